# Optimizing an MI355X kernel written in HIP

```python
import math
import jax
import jax.numpy as jnp
from jax import lax
import numpy as np

D_MODEL = 1024
BATCH = 2
SEQ = 8192
DEPTH = 2

D_MIX = D_MODEL
POOL_WIDTH = D_MIX // 4
POOL_GROUPS = 4
POOL_GC = POOL_WIDTH // POOL_GROUPS
POOL_WINDOWS = (2, 4, 8, 16)
HEAD_DIM = 64
NSA_WIDTH = D_MIX // 2
NSA_HEADS = NSA_WIDTH // HEAD_DIM
NSA_KV_HEADS = 2
NSA_REP = NSA_HEADS // NSA_KV_HEADS
KV_WIDTH = NSA_KV_HEADS * HEAD_DIM
N_BRANCH = 3
GATE_WIDTH = NSA_HEADS * N_BRANCH
S5_WIDTH = D_MIX - POOL_WIDTH - NSA_WIDTH
S5_H = 16
S5_GROUPS = S5_WIDTH // S5_H
S5_P = 64
CMP_STRIDE = 16
CMP_LEN = 32
CMP_HIDDEN = 128
SLC_BLOCK = 64
N_SELECT = 16
WINDOW = 512
Q_BLOCK = 128
FORCE_BONUS = 1000.0
ROT_DIM = HEAD_DIM // 4
ROPE_THETA = 500000.0
EPS = 1e-6
NEG_INF = -1e30
D_FF = 2816
N_MOD = 9
N_IN = POOL_WIDTH + NSA_WIDTH + 6 * KV_WIDTH + GATE_WIDTH + S5_WIDTH
IN_OFFSETS = (POOL_WIDTH, POOL_WIDTH + NSA_WIDTH, POOL_WIDTH + NSA_WIDTH + 6 * KV_WIDTH,
              POOL_WIDTH + NSA_WIDTH + 6 * KV_WIDTH + GATE_WIDTH)
OUT_OFFSETS = (POOL_WIDTH, POOL_WIDTH + NSA_WIDTH)

kernel_name = 'hybrid_pool_nsa_s5_macaron'


def _rms_norm(x, g):
    xf = x.astype(jnp.float32)
    y = xf * lax.rsqrt(jnp.mean(xf * xf, axis=-1, keepdims=True) + EPS)
    return (y * g.astype(jnp.float32)).astype(x.dtype)


def _modulate(h, shift, scale):
    return h * (1.0 + scale[:, None, :]) + shift[:, None, :]


def _swiglu(h, w_in, w_out):
    gate, up = jnp.split(h @ w_in, 2, axis=-1)
    return (jax.nn.silu(gate) * up) @ w_out


def _rope_partial(x, pos):
    half = ROT_DIM // 2
    inv_freq = jnp.exp(-math.log(ROPE_THETA) * jnp.arange(half, dtype=jnp.float32) * (2.0 / ROT_DIM))
    ang = pos[:, None] * inv_freq[None, :]
    cos, sin = jnp.cos(ang), jnp.sin(ang)
    xf = x.astype(jnp.float32)
    x1, x2 = xf[..., :half], xf[..., half:ROT_DIM]
    out = jnp.concatenate([x1 * cos - x2 * sin, x2 * cos + x1 * sin, xf[..., ROT_DIM:]], axis=-1)
    return out.astype(x.dtype)


def _masked_softmax(s, mask):
    return jax.nn.softmax(jnp.where(mask, s.astype(jnp.float32), NEG_INF), axis=-1)


def _pool_mixer(u, pool_w, pool_b, pool_scale):
    B, S, _ = u.shape
    ug = u.reshape(B, S, POOL_GROUPS, POOL_GC)
    count = jnp.arange(1, S + 1, dtype=jnp.float32)[None, :, None]
    outs = []
    for gi, w in enumerate(POOL_WINDOWS):
        v = ug[:, :, gi].astype(jnp.float32)
        cs = jnp.cumsum(v, axis=1)
        lag = jnp.pad(cs[:, :S - w], ((0, 0), (w, 0), (0, 0)))
        outs.append((cs - lag) / jnp.minimum(count, float(w)) - v)
    pooled = jnp.stack(outs, axis=2).astype(u.dtype)
    y = jnp.einsum('bsgc,gcd->bsgd', pooled, pool_w) + pool_b
    return y.reshape(B, S, POOL_WIDTH) * pool_scale


def _nsa_compress(a, pe, w1, w2):
    B, S, G, HD = a.shape
    ch = a.reshape(B, S // CMP_STRIDE, CMP_STRIDE, G, HD)
    blk = jnp.concatenate([ch[:, :-1], ch[:, 1:]], axis=2) + pe[None, None, :, None, :]
    blk = blk.transpose(0, 1, 3, 2, 4).reshape(B, S // CMP_STRIDE - 1, G, CMP_LEN * HD)
    return (jax.nn.gelu(blk @ w1) @ w2).transpose(0, 2, 1, 3)


def _nsa_mixer(u_q, u_kv, u_gate, q_norm, k_norm, cmp_pe, cmp_k_w1, cmp_k_w2, cmp_v_w1, cmp_v_w2):
    B, S, _ = u_q.shape
    G, R, HD = NSA_KV_HEADS, NSA_REP, HEAD_DIM
    dt = u_q.dtype
    pos = jnp.arange(S, dtype=jnp.float32)
    q = u_q.reshape(B, S, G, R, HD).transpose(0, 2, 3, 1, 4)
    q = _rope_partial(_rms_norm(q, q_norm), pos)
    kc, vc, ks, vs, kw, vw = [a.reshape(B, S, G, HD) for a in jnp.split(u_kv, 6, axis=-1)]

    n_cmp = S // CMP_STRIDE - 1
    cmp_end = jnp.arange(n_cmp) * CMP_STRIDE + CMP_LEN - 1
    k_cmp = _rope_partial(_rms_norm(_nsa_compress(kc, cmp_pe[0], cmp_k_w1, cmp_k_w2), k_norm[0]),
                          cmp_end.astype(jnp.float32))
    v_cmp = _nsa_compress(vc, cmp_pe[1], cmp_v_w1, cmp_v_w2)
    k_slc = _rope_partial(_rms_norm(ks.transpose(0, 2, 1, 3), k_norm[1]), pos)
    v_slc = vs.transpose(0, 2, 1, 3)
    k_win = _rope_partial(_rms_norm(kw.transpose(0, 2, 1, 3), k_norm[2]), pos)
    v_win = vw.transpose(0, 2, 1, 3)
    gates = jax.nn.sigmoid(u_gate.astype(jnp.float32).reshape(B, S, G, R, N_BRANCH)
                           .transpose(0, 2, 3, 1, 4))

    n_slc = S // SLC_BLOCK
    n_top = min(N_SELECT, n_slc)
    k_blocks = k_slc.reshape(B, G, n_slc, SLC_BLOCK, HD)
    v_blocks = v_slc.reshape(B, G, n_slc, SLC_BLOCK, HD)
    c_start = jnp.arange(n_cmp)[:, None] * CMP_STRIDE
    s_start = jnp.arange(n_slc)[None, :] * SLC_BLOCK
    overlap = jnp.clip(jnp.minimum(c_start + CMP_LEN, s_start + SLC_BLOCK) - jnp.maximum(c_start, s_start),
                       0, None).astype(jnp.float32) / CMP_LEN
    k_win_pad = jnp.pad(k_win, ((0, 0), (0, 0), (WINDOW, 0), (0, 0)))
    v_win_pad = jnp.pad(v_win, ((0, 0), (0, 0), (WINDOW, 0), (0, 0)))
    bi = jnp.arange(B)[:, None, None, None]
    gi = jnp.arange(G)[None, :, None, None]
    blk_ids = jnp.arange(n_slc)
    scale = HEAD_DIM ** -0.5

    def one_block(b):
        start = b * Q_BLOCK
        t = start + jnp.arange(Q_BLOCK)
        qb = lax.dynamic_slice_in_dim(q, start, Q_BLOCK, axis=3)
        m_cmp = cmp_end[None, :] <= t[:, None]
        s = jnp.einsum('bgrqd,bgnd->bgrqn', qb, k_cmp) * scale
        p_cmp = _masked_softmax(s, m_cmp) * jnp.any(m_cmp, axis=-1)[:, None].astype(jnp.float32)
        o_cmp = jnp.einsum('bgrqn,bgnd->bgrqd', p_cmp.astype(dt), v_cmp)
        imp = jnp.einsum('bgrqn,nj->bgqj', p_cmp, overlap)
        cur = t // SLC_BLOCK
        forced = (blk_ids[None, :] == 0) | (blk_ids[None, :] == cur[:, None]) | (blk_ids[None, :] == cur[:, None] - 1)
        valid = blk_ids[None, :] * SLC_BLOCK <= t[:, None]
        imp = jnp.where(valid, imp + jnp.where(forced, FORCE_BONUS, 0.0), NEG_INF)
        _, idx = lax.top_k(imp, n_top)
        k_sel = k_blocks[bi, gi, idx].reshape(B, G, Q_BLOCK, n_top * SLC_BLOCK, HD)
        v_sel = v_blocks[bi, gi, idx].reshape(B, G, Q_BLOCK, n_top * SLC_BLOCK, HD)
        tok = (idx[..., None] * SLC_BLOCK + jnp.arange(SLC_BLOCK)).reshape(B, G, Q_BLOCK, n_top * SLC_BLOCK)
        m_slc = (tok <= t[:, None])[:, :, None]
        s = jnp.einsum('bgrqd,bgqkd->bgrqk', qb, k_sel) * scale
        o_slc = jnp.einsum('bgrqk,bgqkd->bgrqd', _masked_softmax(s, m_slc).astype(dt), v_sel)
        k_w = lax.dynamic_slice_in_dim(k_win_pad, start, WINDOW + Q_BLOCK, axis=2)
        v_w = lax.dynamic_slice_in_dim(v_win_pad, start, WINDOW + Q_BLOCK, axis=2)
        kp = start - WINDOW + jnp.arange(WINDOW + Q_BLOCK)
        m_win = (kp[None, :] <= t[:, None]) & (kp[None, :] > t[:, None] - WINDOW) & (kp[None, :] >= 0)
        s = jnp.einsum('bgrqd,bgkd->bgrqk', qb, k_w) * scale
        o_win = jnp.einsum('bgrqk,bgkd->bgrqd', _masked_softmax(s, m_win).astype(dt), v_w)
        gb = lax.dynamic_slice_in_dim(gates, start, Q_BLOCK, axis=3)
        o = gb[..., 0:1] * o_cmp + gb[..., 1:2] * o_slc + gb[..., 2:3] * o_win
        return o.astype(dt)

    o = lax.map(one_block, jnp.arange(S // Q_BLOCK))
    return o.transpose(1, 0, 4, 2, 3, 5).reshape(B, S, NSA_WIDTH)


def _s5_mixer(u, lam_re, lam_im, log_dt, b_re, b_im, c_re, c_im, d_skip, glu_w, glu_b):
    B, S, _ = u.shape
    f32 = jnp.float32
    uf = u.astype(f32).reshape(B, S, S5_GROUPS, S5_H)
    lam = lax.complex(lam_re.astype(f32), lam_im.astype(f32))
    step = jnp.exp(log_dt.astype(f32))[:, None]
    lam_bar = jnp.exp(lam * step)
    b_bar = lax.complex(b_re.astype(f32), b_im.astype(f32)) * ((lam_bar - 1.0) / lam)[..., None]
    bu = jnp.einsum('gph,bsgh->bsgp', b_bar, uf.astype(jnp.complex64))
    a = jnp.broadcast_to(lam_bar, bu.shape)

    def combine(e1, e2):
        return (e2[0] * e1[0], e2[0] * e1[1] + e2[1])

    _, states = lax.associative_scan(combine, (a, bu), axis=1)
    c_mat = lax.complex(c_re.astype(f32), c_im.astype(f32))
    y = jnp.einsum('ghp,bsgp->bsgh', c_mat, states).real + d_skip.astype(f32) * uf
    y = jax.nn.gelu(y.reshape(B, S, S5_WIDTH))
    y = y * jax.nn.sigmoid(y @ glu_w.astype(f32) + glu_b.astype(f32))
    return y.astype(u.dtype)


def _hybrid_layer(x, c, ada_w, ada_b, norm_ffn1, ffn1_w_in, ffn1_w_out, norm_mix, w_in, w_out, out_norm,
                  pool_w, pool_b, pool_scale, q_norm, k_norm, cmp_pe, cmp_k_w1, cmp_k_w2, cmp_v_w1, cmp_v_w2,
                  s5_lam_re, s5_lam_im, s5_log_dt, s5_b_re, s5_b_im, s5_c_re, s5_c_im, s5_d, glu_w, glu_b,
                  norm_ffn2, ffn2_w_in, ffn2_w_out):
    B = x.shape[0]
    mod = (jax.nn.silu(c) @ ada_w + ada_b).reshape(B, N_MOD, D_MODEL)
    sh1, sc1, g1, sh2, sc2, g2, sh3, sc3, g3 = [mod[:, i] for i in range(N_MOD)]
    h = _modulate(_rms_norm(x, norm_ffn1), sh1, sc1)
    x = x + 0.5 * g1[:, None, :] * _swiglu(h, ffn1_w_in, ffn1_w_out)
    h = _modulate(_rms_norm(x, norm_mix), sh2, sc2)
    u_pool, u_q, u_kv, u_gate, u_s5 = jnp.split(h @ w_in, IN_OFFSETS, axis=-1)
    n_pool, n_nsa, n_s5 = jnp.split(out_norm, OUT_OFFSETS)
    y_pool = _rms_norm(_pool_mixer(u_pool, pool_w, pool_b, pool_scale), n_pool)
    y_nsa = _rms_norm(_nsa_mixer(u_q, u_kv, u_gate, q_norm, k_norm, cmp_pe, cmp_k_w1, cmp_k_w2,
                                 cmp_v_w1, cmp_v_w2), n_nsa)
    y_s5 = _rms_norm(_s5_mixer(u_s5, s5_lam_re, s5_lam_im, s5_log_dt, s5_b_re, s5_b_im, s5_c_re, s5_c_im,
                               s5_d, glu_w, glu_b), n_s5)
    y = jnp.concatenate([y_pool, y_nsa, y_s5], axis=-1) @ w_out
    x = x + g2[:, None, :] * y
    h = _modulate(_rms_norm(x, norm_ffn2), sh3, sc3)
    x = x + 0.5 * g3[:, None, :] * _swiglu(h, ffn2_w_in, ffn2_w_out)
    return x


def setup_inputs(seed: int = 0) -> dict:
    key = jax.random.key(seed)
    keys = iter(jax.random.split(key, 64))
    L, D = DEPTH, D_MODEL

    def nrm(shape, std):
        return std * jax.random.normal(next(keys), shape, jnp.float32)

    def gain(shape):
        return 1.0 + nrm(shape, 0.02)

    return {
        'x': nrm((BATCH, SEQ, D), 1.0),
        'c': nrm((BATCH, D), 1.0),
        'ada_w': nrm((L, D, N_MOD * D), 0.5 * D ** -0.5),
        'ada_b': nrm((L, N_MOD * D), 0.01),
        'norm_ffn1': gain((L, D)),
        'ffn1_w_in': nrm((L, D, 2 * D_FF), D ** -0.5),
        'ffn1_w_out': nrm((L, D_FF, D), D_FF ** -0.5),
        'norm_mix': gain((L, D)),
        'w_in': nrm((L, D, N_IN), D ** -0.5),
        'w_out': nrm((L, D_MIX, D), D_MIX ** -0.5),
        'out_norm': gain((L, D_MIX)),
        'pool_w': nrm((L, POOL_GROUPS, POOL_GC, POOL_GC), POOL_GC ** -0.5),
        'pool_b': nrm((L, POOL_GROUPS, POOL_GC), 0.01),
        'pool_scale': gain((L, POOL_WIDTH)),
        'q_norm': gain((L, HEAD_DIM)),
        'k_norm': gain((L, N_BRANCH, HEAD_DIM)),
        'cmp_pe': nrm((L, 2, CMP_LEN, HEAD_DIM), 0.02),
        'cmp_k_w1': nrm((L, CMP_LEN * HEAD_DIM, CMP_HIDDEN), (CMP_LEN * HEAD_DIM) ** -0.5),
        'cmp_k_w2': nrm((L, CMP_HIDDEN, HEAD_DIM), CMP_HIDDEN ** -0.5),
        'cmp_v_w1': nrm((L, CMP_LEN * HEAD_DIM, CMP_HIDDEN), (CMP_LEN * HEAD_DIM) ** -0.5),
        'cmp_v_w2': nrm((L, CMP_HIDDEN, HEAD_DIM), CMP_HIDDEN ** -0.5),
        's5_lam_re': -0.5 + nrm((L, S5_GROUPS, S5_P), 0.01),
        's5_lam_im': math.pi * jnp.arange(S5_P, dtype=jnp.float32) + nrm((L, S5_GROUPS, S5_P), 0.01),
        's5_log_dt': jax.random.uniform(next(keys), (L, S5_GROUPS), jnp.float32,
                                        math.log(1e-3), math.log(1e-1)),
        's5_b_re': nrm((L, S5_GROUPS, S5_P, S5_H), (2 * S5_H) ** -0.5),
        's5_b_im': nrm((L, S5_GROUPS, S5_P, S5_H), (2 * S5_H) ** -0.5),
        's5_c_re': nrm((L, S5_GROUPS, S5_H, S5_P), S5_P ** -0.5),
        's5_c_im': nrm((L, S5_GROUPS, S5_H, S5_P), S5_P ** -0.5),
        's5_d': nrm((L, S5_GROUPS, S5_H), 1.0),
        'glu_w': nrm((L, S5_WIDTH, S5_WIDTH), S5_WIDTH ** -0.5),
        'glu_b': nrm((L, S5_WIDTH), 0.01),
        'norm_ffn2': gain((L, D)),
        'ffn2_w_in': nrm((L, D, 2 * D_FF), D ** -0.5),
        'ffn2_w_out': nrm((L, D_FF, D), D_FF ** -0.5),
    }


def reference(x, c, ada_w, ada_b, norm_ffn1, ffn1_w_in, ffn1_w_out, norm_mix, w_in, w_out, out_norm,
              pool_w, pool_b, pool_scale, q_norm, k_norm, cmp_pe, cmp_k_w1, cmp_k_w2, cmp_v_w1, cmp_v_w2,
              s5_lam_re, s5_lam_im, s5_log_dt, s5_b_re, s5_b_im, s5_c_re, s5_c_im, s5_d, glu_w, glu_b,
              norm_ffn2, ffn2_w_in, ffn2_w_out):
    for l in range(DEPTH):
        x = _hybrid_layer(x, c, ada_w[l], ada_b[l], norm_ffn1[l], ffn1_w_in[l], ffn1_w_out[l], norm_mix[l],
                          w_in[l], w_out[l], out_norm[l], pool_w[l], pool_b[l], pool_scale[l], q_norm[l],
                          k_norm[l], cmp_pe[l], cmp_k_w1[l], cmp_k_w2[l], cmp_v_w1[l], cmp_v_w2[l],
                          s5_lam_re[l], s5_lam_im[l], s5_log_dt[l], s5_b_re[l], s5_b_im[l], s5_c_re[l],
                          s5_c_im[l], s5_d[l], glu_w[l], glu_b[l], norm_ffn2[l], ffn2_w_in[l], ffn2_w_out[l])
    return x
```

```cpp
#include <hip/hip_runtime.h>
#include <hip/hip_cooperative_groups.h>
#include <cstdio>
#include <cstdint>
#include <cmath>
namespace pg8 {
#define PG8_LAS __attribute__((address_space(3)))
typedef unsigned short bf16_t;
typedef short bf16x8 __attribute__((ext_vector_type(8)));
typedef float f32x4 __attribute__((ext_vector_type(4)));
typedef unsigned u32x4 __attribute__((ext_vector_type(4)));
constexpr int BM = 256, BK = 64, HALF = 128, HTB = HALF * BK * 2  , STAGE_BYTES = 8 * HTB, NXCD = 8, WGM = 8;

__host__ __device__ __forceinline__ int lds_byte(int r, int c) { const int st = (r >> 4) * 2 + (c >> 5), rr = r & 15, cc = c & 31, ob = rr * 64 + cc * 2; return st * 1024 + (ob ^ (((ob >> 9) & 1) << 5)); }
__host__ __device__ __forceinline__ void stage_rc(int b, int& R, int& C) { const int st = b / 1024, sb = b % 1024, swz = sb ^ (((sb >> 9) & 1) << 5); R = (st >> 1) * 16 + swz / 64; C = (st & 1) * 32 + (swz % 64) / 2; }
__host__ __device__ __forceinline__ int perm32(int rho) { const int n = rho >> 4, i = rho & 15; return 8 * (i >> 2) + 4 * n + (i & 3); }

struct Unit { int pm, pn; };
struct Gemm { const bf16_t* A; const bf16_t* Bt; int M, N, K; };

struct StaticOrder {
    int nM, nN, nwg, G, c;
    __host__ __device__ void init(int M, int N, int G_, int c_) { nM = M / BM; nN = N / BM; nwg = nM * nN; G = G_; c = c_; }
    __host__ __device__ bool next(int i, Unit& u) const {
        const long L = (long)i * G + c; if (L >= nwg) return false;
        int wgid = (int)L; { const int q = nwg / NXCD, r = nwg % NXCD, xcd = wgid % NXCD, off = wgid / NXCD; wgid = (xcd < r ? xcd * (q + 1) : r * (q + 1) + (xcd - r) * q) + off; }
        const int nig = WGM * nN, gid = wgid / nig, fm = gid * WGM, gsz = (nM - fm) < WGM ? (nM - fm) : WGM;
        u.pm = fm + ((wgid % nig) % gsz); u.pn = (wgid % nig) / gsz; return true;
    }
    __device__ __forceinline__ void a_ready(const Unit&) const {}
    __device__ __forceinline__ void done(const Unit&) const {}
};

__device__ __forceinline__ unsigned cvt_pk_bf16(float lo, float hi) { unsigned r; asm volatile("v_cvt_pk_bf16_f32 %0, %1, %2" : "=v"(r) : "v"(lo), "v"(hi)); return r; }
typedef float f32x2 __attribute__((ext_vector_type(2)));
struct EpiSwiGLU {
    static constexpr bool PERM = true, AFTER_DRAIN = false;
    bf16_t* H; int ldh;
    __device__ __forceinline__ void operator()(const f32x4 (&acc)[2][2][4][2], const Unit& u, int wr, int wc, int fr, int fq) const {
        const int row0 = u.pm * BM + wr * 64 + fr; const int col0 = u.pn * HALF + wc * 32 + 8 * fq;
#pragma unroll
        for (int ai = 0; ai < 2; ++ai)
#pragma unroll
            for (int m = 0; m < 4; ++m) { bf16_t* rowp = H + (size_t)(row0 + ai * HALF + m * 16) * ldh + col0;
                float h[8];
#pragma unroll
                for (int n = 0; n < 2; ++n)
#pragma unroll
                    for (int i = 0; i < 4; ++i) { const float g = acc[ai][0][m][n][i], up = acc[ai][1][m][n][i]; h[4 * n + i] = g * up * __builtin_amdgcn_rcpf(1.0f + __expf(-g)); }
                u32x4 w; w.x = cvt_pk_bf16(h[0], h[1]); w.y = cvt_pk_bf16(h[2], h[3]); w.z = cvt_pk_bf16(h[4], h[5]); w.w = cvt_pk_bf16(h[6], h[7]);
                *(u32x4*)rowp = w; }
    }
};
struct EpiResid {
    static constexpr bool PERM = false, AFTER_DRAIN = false;
    const float* base; float* out; const float* gate; int gstride; float coef; int ldc;
    __device__ __forceinline__ void operator()(const f32x4 (&acc)[2][2][4][2], const Unit& u, int wr, int wc, int fr, int fq) const {
        const int b = (u.pm * BM) >> 13; const float* gp = gate + (size_t)b * gstride;
        const int col0 = u.pn * BM + wc * 32 + 4 * fq;
        f32x4 gv[2][2];
#pragma unroll
        for (int bj = 0; bj < 2; ++bj)
#pragma unroll
            for (int n = 0; n < 2; ++n) gv[bj][n] = *(const f32x4*)(gp + col0 + bj * HALF + n * 16) * coef;
#pragma unroll
        for (int ai = 0; ai < 2; ++ai)
#pragma unroll
            for (int m = 0; m < 4; ++m) { const size_t off = (size_t)(u.pm * BM + ai * HALF + wr * 64 + m * 16 + fr) * ldc + col0;
#pragma unroll
                for (int bj = 0; bj < 2; ++bj)
#pragma unroll
                    for (int n = 0; n < 2; ++n) { const f32x4 bs = *(const f32x4*)(base + off + bj * HALF + n * 16);
                        *(f32x4*)(out + off + bj * HALF + n * 16) = bs + gv[bj][n] * acc[ai][bj][m][n]; }
                asm volatile("" ::: "memory"); }
    }
};
struct EpiF32 {
    static constexpr bool PERM = false, AFTER_DRAIN = false;
    float* O; int ldc;
    __device__ __forceinline__ void operator()(const f32x4 (&acc)[2][2][4][2], const Unit& u, int wr, int wc, int fr, int fq) const {
        const int col0 = u.pn * BM + wc * 32 + 4 * fq;
#pragma unroll
        for (int ai = 0; ai < 2; ++ai)
#pragma unroll
            for (int m = 0; m < 4; ++m) { const size_t off = (size_t)(u.pm * BM + ai * HALF + wr * 64 + m * 16 + fr) * ldc + col0;
#pragma unroll
                for (int bj = 0; bj < 2; ++bj)
#pragma unroll
                    for (int n = 0; n < 2; ++n) *(f32x4*)(O + off + bj * HALF + n * 16) = acc[ai][bj][m][n];
                asm volatile("" ::: "memory"); }
    }
};
template <class Epi, class Sched, bool ALIGN_EPI = false, bool SP2 = false>
__device__ __forceinline__ void gemm_phase(PG8_LAS unsigned char* lds, const Gemm g, const Sched& S, const Epi& E) {
    int tid_ = threadIdx.x; asm volatile("" : "+v"(tid_)); const int tid = tid_, wid = __builtin_amdgcn_readfirstlane(tid >> 6), lane = tid & 63, wr = wid >> 2, wc = wid & 3, fr = lane & 15, fq = lane >> 4;
    const int K = g.K, nt = K / BK;
    unsigned voffA[2], voffB[2];
#pragma unroll
    for (int i = 0; i < 2; ++i) { int R, C; stage_rc(tid * 16 + i * 8192, R, C); const int Rb = Epi::PERM ? ((R & ~31) + perm32(R & 31)) : R;
        voffA[i] = (unsigned)(R * K + C) * 2u; voffB[i] = (unsigned)(Rb * K + C) * 2u; }
    const size_t kstep = (size_t)(BK * 2);
    const size_t hstep = (size_t)HALF * K * 2;
    const size_t tstep = 2 * hstep;
    const unsigned ldsw = (unsigned)wid * 1024u;
    const int aoff = lds_byte(wr * 64 + fr, fq * 8), boff = lds_byte(wc * 32 + fr, fq * 8);
#define PG8_SA(b, h) (((b) * 2 + (h)) * HTB)
#define PG8_SB(b, h) ((4 + (b) * 2 + (h)) * HTB)
#define PG8_STAGE(bufoff, gbase, voff) do { _Pragma("unroll") for (int _i = 0; _i < 2; ++_i) \
        __builtin_amdgcn_global_load_lds((const unsigned*)((const char*)(gbase) + (voff)[_i]), (PG8_LAS unsigned*)(lds + (bufoff) + ldsw + _i * 8192), 16, 0, 0); } while (0)
#define PG8_LDA(dst, b, h) do { _Pragma("unroll") for (int m = 0; m < 4; ++m) _Pragma("unroll") for (int k = 0; k < 2; ++k) dst[m][k] = *(const PG8_LAS bf16x8*)(lds + PG8_SA(b, h) + aoff + m * 2048 + k * 1024); } while (0)
#define PG8_LDB(dst, b, h) do { _Pragma("unroll") for (int n = 0; n < 2; ++n) _Pragma("unroll") for (int k = 0; k < 2; ++k) dst[n][k] = *(const PG8_LAS bf16x8*)(lds + PG8_SB(b, h) + boff + n * 2048 + k * 1024); } while (0)
#define PG8_MMA(ai, bj, At, Bt) do { __builtin_amdgcn_s_setprio(1); _Pragma("unroll") for (int m = 0; m < 4; ++m) _Pragma("unroll") for (int n = 0; n < 2; ++n) _Pragma("unroll") for (int k = 0; k < 2; ++k) \
        acc[ai][bj][m][n] = __builtin_amdgcn_mfma_f32_16x16x32_bf16(Bt[n][k], At[m][k], acc[ai][bj][m][n], 0, 0, 0); __builtin_amdgcn_s_setprio(0); } while (0)
#define PG8_WAIT_V(n) asm volatile("s_waitcnt vmcnt(" #n ")" ::: "memory")
#define PG8_WAIT_L(n) asm volatile("s_waitcnt lgkmcnt(" #n ")" ::: "memory")
#define PG8_BAR __builtin_amdgcn_s_barrier()
#define PG8_SCHED __builtin_amdgcn_sched_barrier(0)
    Unit cur, nxt; int ui = 0;
    if (!S.next(0, cur)) return;
    f32x4 acc[2][2][4][2];
#pragma unroll
    for (int a = 0; a < 2; ++a)
#pragma unroll
        for (int b = 0; b < 2; ++b)
#pragma unroll
            for (int m = 0; m < 4; ++m)
#pragma unroll
                for (int n = 0; n < 2; ++n) acc[a][b][m][n] = (f32x4){0.f, 0.f, 0.f, 0.f};
    bf16x8 At[4][2], B0[2][2], B1[2][2];
    const char* cA = (const char*)g.A + (size_t)cur.pm * tstep; const char* cB = (const char*)g.Bt + (size_t)cur.pn * tstep;
    S.a_ready(cur);
    if constexpr (SP2) {
        PG8_STAGE(PG8_SB(0, 0), cB, voffB); PG8_STAGE(PG8_SB(0, 1), cB + hstep, voffB); PG8_STAGE(PG8_SA(0, 0), cA, voffA); PG8_STAGE(PG8_SA(0, 1), cA + hstep, voffA);
        if (wr == 1) PG8_BAR;
        PG8_WAIT_V(2); PG8_BAR;
        PG8_STAGE(PG8_SB(1, 0), cB + kstep, voffB); PG8_STAGE(PG8_SA(1, 0), cA + kstep, voffA); PG8_STAGE(PG8_SB(1, 1), cB + hstep + kstep, voffB);
        PG8_WAIT_V(6); PG8_BAR;
    } else {
        PG8_STAGE(PG8_SB(0, 0), cB, voffB); PG8_STAGE(PG8_SA(0, 0), cA, voffA); PG8_STAGE(PG8_SB(0, 1), cB + hstep, voffB); PG8_STAGE(PG8_SA(0, 1), cA + hstep, voffA);
        if (wr == 1) PG8_BAR;
        PG8_WAIT_V(4); PG8_BAR;
        PG8_STAGE(PG8_SB(1, 0), cB + kstep, voffB); PG8_STAGE(PG8_SA(1, 0), cA + kstep, voffA); PG8_STAGE(PG8_SB(1, 1), cB + hstep + kstep, voffB);
        PG8_WAIT_V(6); PG8_BAR;
    }
    for (;;) {
        const bool has_next = S.next(ui + 1, nxt);
        const char* nA = has_next ? (const char*)g.A + (size_t)nxt.pm * tstep : cA; const char* nB = has_next ? (const char*)g.Bt + (size_t)nxt.pn * tstep : cB;
        for (int t = 0; t < nt; t += 2) {
            const bool last = (t == nt - 2);
            const char* a1 = cA + (size_t)(t + 1) * kstep;
            const char* a2 = last ? nA : cA + (size_t)(t + 2) * kstep; const char* b2 = last ? nB : cB + (size_t)(t + 2) * kstep;
            const char* a3 = a2 + kstep; const char* b3 = b2 + kstep;
            if (last && has_next) S.a_ready(nxt);
            if constexpr (SP2) {
            PG8_LDB(B0, 0, 0); PG8_LDB(B1, 0, 1); PG8_SCHED; PG8_LDA(At, 0, 0); PG8_STAGE(PG8_SA(1, 1), a1 + hstep, voffA);
            PG8_WAIT_V(8); PG8_WAIT_L(0); PG8_BAR; PG8_MMA(0, 0, At, B0); PG8_MMA(0, 1, At, B1); PG8_BAR; PG8_SCHED;
            PG8_LDA(At, 0, 1); PG8_STAGE(PG8_SB(0, 0), b2, voffB); PG8_STAGE(PG8_SB(0, 1), b2 + hstep, voffB); PG8_STAGE(PG8_SA(0, 0), a2, voffA);
            PG8_WAIT_V(8); PG8_WAIT_L(0); PG8_BAR; PG8_MMA(1, 0, At, B0); PG8_MMA(1, 1, At, B1); PG8_BAR; PG8_SCHED;
            PG8_LDB(B0, 1, 0); PG8_LDB(B1, 1, 1); PG8_SCHED; PG8_LDA(At, 1, 0); PG8_STAGE(PG8_SA(0, 1), a2 + hstep, voffA);
            PG8_WAIT_V(8); PG8_WAIT_L(0); PG8_BAR; PG8_MMA(0, 0, At, B0); PG8_MMA(0, 1, At, B1); PG8_BAR; PG8_SCHED;
            PG8_LDA(At, 1, 1); PG8_STAGE(PG8_SB(1, 0), b3, voffB); PG8_STAGE(PG8_SB(1, 1), b3 + hstep, voffB); PG8_STAGE(PG8_SA(1, 0), a3, voffA);
            PG8_WAIT_V(8); PG8_WAIT_L(0); PG8_BAR; PG8_MMA(1, 0, At, B0); PG8_MMA(1, 1, At, B1); PG8_BAR; PG8_SCHED;
            } else {
            PG8_LDB(B0, 0, 0); PG8_SCHED; PG8_LDA(At, 0, 0); PG8_STAGE(PG8_SA(1, 1), a1 + hstep, voffA);
            PG8_WAIT_L(8); PG8_BAR; PG8_WAIT_L(0); PG8_MMA(0, 0, At, B0); PG8_BAR; PG8_SCHED;
            PG8_LDB(B1, 0, 1); PG8_STAGE(PG8_SB(0, 0), b2, voffB);
            PG8_BAR; PG8_WAIT_L(0); PG8_MMA(0, 1, At, B1); PG8_BAR;
            PG8_LDA(At, 0, 1); PG8_STAGE(PG8_SA(0, 0), a2, voffA);
            PG8_BAR; PG8_WAIT_L(0); PG8_MMA(1, 0, At, B0); PG8_BAR; PG8_SCHED;
            PG8_STAGE(PG8_SB(0, 1), b2 + hstep, voffB);
            PG8_WAIT_V(6); PG8_BAR; PG8_MMA(1, 1, At, B1); PG8_BAR;
            PG8_LDB(B0, 1, 0); PG8_SCHED; PG8_LDA(At, 1, 0); PG8_STAGE(PG8_SA(0, 1), a2 + hstep, voffA);
            PG8_WAIT_L(8); PG8_BAR; PG8_WAIT_L(0); PG8_MMA(0, 0, At, B0); PG8_BAR; PG8_SCHED;
            PG8_LDB(B1, 1, 1); PG8_STAGE(PG8_SB(1, 0), b3, voffB);
            PG8_BAR; PG8_WAIT_L(0); PG8_MMA(0, 1, At, B1); PG8_BAR;
            PG8_LDA(At, 1, 1); PG8_STAGE(PG8_SA(1, 0), a3, voffA);
            PG8_BAR; PG8_WAIT_L(0); PG8_MMA(1, 0, At, B0); PG8_BAR; PG8_SCHED;
            PG8_STAGE(PG8_SB(1, 1), b3 + hstep, voffB);
            PG8_WAIT_V(6); PG8_BAR; PG8_MMA(1, 1, At, B1); PG8_BAR;
            }
        }
        if constexpr (ALIGN_EPI) { if (wr == 0) PG8_BAR; }
        if constexpr (!Epi::AFTER_DRAIN) { E(acc, cur, wr, wc, fr, fq); S.done(cur); }
        if (!has_next) break;
#pragma unroll
        for (int a = 0; a < 2; ++a)
#pragma unroll
            for (int b = 0; b < 2; ++b)
#pragma unroll
                for (int m = 0; m < 4; ++m)
#pragma unroll
                    for (int n = 0; n < 2; ++n) acc[a][b][m][n] = (f32x4){0.f, 0.f, 0.f, 0.f};
        cur = nxt; cA = nA; cB = nB; ++ui;
        if constexpr (ALIGN_EPI) { if (wr == 1) PG8_BAR; }
    }
    PG8_WAIT_V(0);
    if constexpr (!ALIGN_EPI) { if (wr == 0) PG8_BAR; }
    PG8_BAR;
    if constexpr (Epi::AFTER_DRAIN) { E.fused(acc, cur, wr, wc, fr, fq, lds, wid, lane); S.done(cur); }
#undef PG8_SA
#undef PG8_SB
#undef PG8_STAGE
#undef PG8_LDA
#undef PG8_LDB
#undef PG8_MMA
#undef PG8_WAIT_V
#undef PG8_WAIT_L
#undef PG8_BAR
#undef PG8_SCHED
}
}

namespace cg = cooperative_groups;
typedef unsigned short bf16;
typedef float f32x16 __attribute__((ext_vector_type(16)));
typedef short bf16x8v __attribute__((ext_vector_type(8)));
constexpr int NWV = 8, NTHR = 512;
constexpr int SEQ = 8192, DM = 1024, MTOK = 16384, DFF = 2816, NIN = 1816, NINP = 2048, NMOD = 9216;
constexpr int C_Q = 256, C_KC = 768, C_KS = 1024, C_VS = 1152, C_KW = 1280, C_VW = 1408, C_GATE = 1536, C_S5 = 1560;
constexpr float EPSN = 1e-6f;
constexpr size_t MiB = 1u << 20;
constexpr size_t WS_A = 0;
constexpr size_t WS_XN = 128 * MiB;
constexpr size_t WS_W1T = 160 * MiB;
constexpr size_t WS_W2T = 182 * MiB;
constexpr size_t WS_WINT = 193 * MiB;
constexpr size_t WS_WOUTT = 197 * MiB;
constexpr size_t WS_QN = 200 * MiB;
constexpr size_t WS_KS = 232 * MiB;
constexpr size_t WS_KW = 240 * MiB;
constexpr size_t WS_YS5 = 248 * MiB;
constexpr size_t WS_MOD = 264 * MiB;
constexpr size_t WS_ROPE = 265 * MiB;
constexpr size_t WS_KCMP = 266 * MiB;
constexpr size_t WS_VCMP = 266 * MiB + 512 * 1024;
constexpr size_t WS_S5END = 267 * MiB;
constexpr size_t WS_VTS = 269 * MiB;
constexpr size_t WS_VTW = 273 * MiB;
constexpr size_t WS_VTC = 277 * MiB;
constexpr size_t WS_CTL = 278 * MiB;
constexpr size_t CTL_BYTES = 16384;
constexpr size_t WS_WCT = 279 * MiB;
constexpr size_t WS_GLUT = 280 * MiB;
constexpr size_t WS_S5T = 281 * MiB;
constexpr size_t WS_END = 282 * MiB;
constexpr int LDS_BYTES = 147456;

struct KP { const float* in[36]; int ph_lo, ph_hi; };
#define PIN(i) (p.in[(i) + z_])
#define PWS ((unsigned char*)p.in[35 + z_])
#define POUT ((float*)p.in[34 + z_])
#define ZDEF int z_ = 0; asm volatile("" : "+s"(z_))

__device__ __forceinline__ float wsum(float v) {
#define DPPADD_(ctrl, rmask) { const int t_ = __builtin_amdgcn_update_dpp(0, __float_as_int(v), ctrl, rmask, 0xf, false); v += __int_as_float(t_); }
    DPPADD_(0x111, 0xf) DPPADD_(0x112, 0xf) DPPADD_(0x114, 0xf) DPPADD_(0x118, 0xf) DPPADD_(0x142, 0xa) DPPADD_(0x143, 0xc)
#undef DPPADD_
    return __int_as_float(__builtin_amdgcn_readlane(__float_as_int(v), 63));
}
__device__ __forceinline__ float qsum(float v) {
    v += __int_as_float(__builtin_amdgcn_mov_dpp(__float_as_int(v), 0xB1, 0xf, 0xf, true));
    v += __int_as_float(__builtin_amdgcn_mov_dpp(__float_as_int(v), 0x4E, 0xf, 0xf, true));
    return v;
}
__device__ __forceinline__ float wmax(float v) {
#pragma unroll
    for (int o = 32; o > 0; o >>= 1) v = fmaxf(v, __shfl_xor(v, o));
    return v;
}
__device__ __forceinline__ unsigned f2bf(float f) { unsigned u = __builtin_bit_cast(unsigned, f); return (u + 0x7fffu + ((u >> 16) & 1u)) >> 16; }
__device__ __forceinline__ unsigned pk2(float lo, float hi) { return f2bf(lo) | (f2bf(hi) << 16); }
__device__ __forceinline__ float gelu_t(float x) { const float z = 1.5957691216057308f * (x + 0.044715f * x * x * x); return x * __builtin_amdgcn_rcpf(1.0f + __expf(-z)); }
__device__ __forceinline__ float sigm(float x) { return __builtin_amdgcn_rcpf(1.0f + __expf(-x)); }
__device__ __forceinline__ int ltid() { int t = threadIdx.x; asm volatile("" : "+v"(t)); return t; }

__device__ __forceinline__ float wave_max_dpp(float v) {
#define DPPMAX_(ctrl, rmask) { const int t_ = __builtin_amdgcn_update_dpp((int)0xff800000, __float_as_int(v), ctrl, rmask, 0xf, false); v = fmaxf(v, __int_as_float(t_)); }
    DPPMAX_(0x111, 0xf) DPPMAX_(0x112, 0xf) DPPMAX_(0x114, 0xf) DPPMAX_(0x118, 0xf) DPPMAX_(0x142, 0xa) DPPMAX_(0x143, 0xc)
#undef DPPMAX_
    return __int_as_float(__builtin_amdgcn_readlane(__float_as_int(v), 63));
}
#define LDSW() asm volatile("s_waitcnt lgkmcnt(0)" ::: "memory")

__device__ __forceinline__ void ph_mod_rope(const KP& p, float* lds) {
    ZDEF;
    const int tid = ltid(), wave = __builtin_amdgcn_readfirstlane(tid >> 6), lane = tid & 63;
    for (int i = tid; i < 2048; i += NTHR) { const float c = PIN(1)[i]; lds[i] = c / (1.0f + expf(-c)); }
    __syncthreads();
    float* red = lds + 2048;
    float* mod = (float*)(PWS + WS_MOD);
    for (int item = blockIdx.x; item < 144; item += gridDim.x) {
        const int l = item / 72, n0 = (item % 72) * 128;
        const float* W = PIN(2) + (size_t)l * 1024 * NMOD + n0 + 2 * lane;
        float a00 = 0.f, a01 = 0.f, a10 = 0.f, a11 = 0.f;
#pragma unroll 16
        for (int kk = 0; kk < 128; ++kk) { const int k = wave * 128 + kk; const float2 w = *(const float2*)(W + (size_t)k * NMOD); const float s0 = lds[k], s1 = lds[1024 + k];
            a00 += s0 * w.x; a01 += s0 * w.y; a10 += s1 * w.x; a11 += s1 * w.y; }
        red[(wave * 2 + 0) * 128 + 2 * lane] = a00; red[(wave * 2 + 0) * 128 + 2 * lane + 1] = a01;
        red[(wave * 2 + 1) * 128 + 2 * lane] = a10; red[(wave * 2 + 1) * 128 + 2 * lane + 1] = a11;
        __syncthreads();
        if (tid < 256) { const int b = tid >> 7, n = tid & 127; float s = 0.f;
#pragma unroll
            for (int w = 0; w < 8; ++w) s += red[(w * 2 + b) * 128 + n];
            mod[(size_t)(l * 2 + b) * NMOD + n0 + n] = s + PIN(3)[l * NMOD + n0 + n]; }
        __syncthreads();
    }
    const int gid = blockIdx.x * NTHR + tid;
    if (gid < SEQ * 8) { const int s = gid >> 3, i = gid & 7;
        const float inv = expf(-13.122363377404328f * (float)i * 0.125f); const float ang = (float)s * inv;
        float sn, cs; sincosf(ang, &sn, &cs);
        float* rope = (float*)(PWS + WS_ROPE); rope[s * 16 + i] = cs; rope[s * 16 + 8 + i] = sn; }
}

template <int MODE> __device__ __forceinline__ void cvt_item(const float* W, int K, int N, bf16* WT, float* scr, int item, int lane) {
    const int nblk = (N + 31) / 32, kb = item / nblk, nb = item % nblk, k0 = 64 * kb, n0 = 32 * nb;
    const int nn = n0 + (lane & 31);
#pragma unroll 32
    for (int i = 0; i < 32; ++i) { const int kk = 2 * i + (lane >> 5); scr[kk * 33 + (lane & 31)] = (nn < N) ? W[(size_t)(k0 + kk) * N + nn] : 0.f; }
    LDSW();
    const int c = lane & 7;
#pragma unroll
    for (int j = 0; j < 4; ++j) { const int nl = (lane >> 3) + 8 * j, n = n0 + nl; const float* s = scr + (8 * c) * 33 + nl;
        uint4 o; o.x = pk2(s[0 * 33], s[1 * 33]); o.y = pk2(s[2 * 33], s[3 * 33]); o.z = pk2(s[4 * 33], s[5 * 33]); o.w = pk2(s[6 * 33], s[7 * 33]);
        int row = n;
        if (MODE == 1) { const int up = n >= DFF ? 1 : 0, n2 = n - up * DFF; row = 256 * (n2 >> 7) + (n2 & 127) + 128 * up; }
        if (n < N) *(uint4*)(WT + (size_t)row * K + k0 + 8 * c) = o; }
    LDSW();
}

__device__ __forceinline__ void ph_convert(const KP& p, int l, float* lds) {
    ZDEF;
    const int tid = ltid(), wave = __builtin_amdgcn_readfirstlane(tid >> 6), lane = tid & 63;
    const int gw = blockIdx.x * NWV + wave, NGW = gridDim.x * NWV;
    float* scr = lds + wave * (64 * 33 + 16);
    constexpr int I_1 = 16 * 176, I_2 = 44 * 32, I_IN = 16 * 57, I_OUT = 16 * 32, I_Z = 232 * 2;
    constexpr int I_C = 32 * 4;
    constexpr int I_G = 4 * 8;
    constexpr int NITEMS = 2 * I_1 + 2 * I_2 + I_IN + I_OUT + I_Z + 2 * I_C + I_G;
    bf16* W1T = (bf16*)(PWS + WS_W1T); bf16* W2T = (bf16*)(PWS + WS_W2T); bf16* WINT = (bf16*)(PWS + WS_WINT); bf16* WOUTT = (bf16*)(PWS + WS_WOUTT);
    for (int it = gw; it < NITEMS; it += NGW) {
        int r = it;
        if (r < I_1) { cvt_item<1>(PIN(5) + (size_t)l * DM * 2 * DFF, DM, 2 * DFF, W1T, scr, r, lane); continue; } r -= I_1;
        if (r < I_1) { cvt_item<1>(PIN(32) + (size_t)l * DM * 2 * DFF, DM, 2 * DFF, W1T + (size_t)2 * DFF * DM, scr, r, lane); continue; } r -= I_1;
        if (r < I_2) { cvt_item<0>(PIN(6) + (size_t)l * DFF * DM, DFF, DM, W2T, scr, r, lane); continue; } r -= I_2;
        if (r < I_2) { cvt_item<0>(PIN(33) + (size_t)l * DFF * DM, DFF, DM, W2T + (size_t)DM * DFF, scr, r, lane); continue; } r -= I_2;
        if (r < I_IN) { cvt_item<0>(PIN(8) + (size_t)l * DM * NIN, DM, NIN, WINT, scr, r, lane); continue; } r -= I_IN;
        if (r < I_OUT) { cvt_item<0>(PIN(9) + (size_t)l * DM * DM, DM, DM, WOUTT, scr, r, lane); continue; } r -= I_OUT;
        if (r >= I_Z + 2 * I_C) { r -= I_Z + 2 * I_C; cvt_item<0>(PIN(29) + (size_t)l * 65536, 256, 256, (bf16*)(PWS + WS_GLUT), scr, r, lane); continue; }
        if (r >= I_Z) { r -= I_Z; const int kvx = r >= I_C ? 1 : 0; r -= kvx * I_C;
            cvt_item<0>((kvx ? PIN(19) : PIN(17)) + (size_t)l * 2048 * 128, 2048, 128, (bf16*)(PWS + WS_WCT) + (size_t)kvx * 128 * 2048, scr, r, lane); continue; }
        { const int row = NIN + (r >> 1), half = r & 1; *(uint4*)(WINT + (size_t)row * DM + half * 512 + lane * 8) = make_uint4((unsigned)z_, (unsigned)z_, (unsigned)z_, (unsigned)z_); }
    }
}

__device__ __forceinline__ void ph_norm(const float* x, const float* gain, const float* modl, int ish, bf16* XN) {
    const int tid = ltid(), wave = __builtin_amdgcn_readfirstlane(tid >> 6), lane = tid & 63;
    const int gw = blockIdx.x * NWV + wave, NGW = gridDim.x * NWV;
    for (int m = gw; m < MTOK; m += NGW) {
        const int b = m >> 13;
        const float4* xr = (const float4*)(x + (size_t)m * DM) + lane;
        float4 v[4]; float ss = 0.f;
#pragma unroll
        for (int j = 0; j < 4; ++j) { v[j] = xr[64 * j]; ss += (v[j].x * v[j].x + v[j].y * v[j].y) + (v[j].z * v[j].z + v[j].w * v[j].w); }
        const float rinv = rsqrtf(wsum(ss) * (1.0f / DM) + EPSN);
        const float* sh = modl + (size_t)b * NMOD + ish * DM; const float* sc = sh + DM;
#pragma unroll
        for (int j = 0; j < 4; ++j) { const int col = 4 * lane + 256 * j;
            const float4 g4 = *(const float4*)(gain + col), s4 = *(const float4*)(sc + col), h4 = *(const float4*)(sh + col);
            const float o0 = v[j].x * rinv * g4.x * (1.0f + s4.x) + h4.x, o1 = v[j].y * rinv * g4.y * (1.0f + s4.y) + h4.y;
            const float o2 = v[j].z * rinv * g4.z * (1.0f + s4.z) + h4.z, o3 = v[j].w * rinv * g4.w * (1.0f + s4.w) + h4.w;
            uint2 o; o.x = pk2(o0, o1); o.y = pk2(o2, o3); *(uint2*)(XN + (size_t)m * DM + col) = o; }
    }
}

__device__ __forceinline__ void s5_setup(const KP& p, int l, int g, int lane, float& lbr, float& lbi, float (&bre)[16], float (&bim)[16], float& are, float& aim) {
    ZDEF;
    const float lre = PIN(21)[l * 1024 + g * 64 + lane], lim = PIN(22)[l * 1024 + g * 64 + lane], step = expf(PIN(23)[l * 16 + g]);
    are = lre * step; aim = lim * step;
    const float em1 = expm1f(are), e = em1 + 1.0f; float sn, cs; sincosf(aim, &sn, &cs);
    float sh, chh; sincosf(0.5f * aim, &sh, &chh);
    lbr = e * cs; lbi = e * sn;
    const float nr = em1 * cs - 2.0f * sh * sh, ni = lbi;
    const float den = 1.0f / (lre * lre + lim * lim);
    const float cr = (nr * lre + ni * lim) * den, ci = (ni * lre - nr * lim) * den;
    const float4* br4 = (const float4*)(PIN(24) + ((size_t)(l * 16 + g) * 64 + lane) * 16);
    const float4* bi4 = (const float4*)(PIN(25) + ((size_t)(l * 16 + g) * 64 + lane) * 16);
#pragma unroll
    for (int q = 0; q < 4; ++q) { const float4 a = br4[q], c = bi4[q];
        bre[4 * q + 0] = a.x * cr - c.x * ci; bim[4 * q + 0] = a.x * ci + c.x * cr;
        bre[4 * q + 1] = a.y * cr - c.y * ci; bim[4 * q + 1] = a.y * ci + c.y * cr;
        bre[4 * q + 2] = a.z * cr - c.z * ci; bim[4 * q + 2] = a.z * ci + c.z * cr;
        bre[4 * q + 3] = a.w * cr - c.w * ci; bim[4 * q + 3] = a.w * ci + c.w * cr; }
}

__device__ __forceinline__ void ph_s5_table(const KP& p) {
    ZDEF;
    const int tid = ltid();
    const int gid = blockIdx.x * NTHR + tid;
    if (gid < 2048) { const int l = gid >> 10, g = (gid >> 6) & 15, lane = gid & 63;
        float lbr, lbi, bre[16], bim[16], are, aim; s5_setup(p, l, g, lane, lbr, lbi, bre, bim, are, aim);
        float Lr, Li; { const float e = expf(are * 64.0f); float sn, cs; sincosf(aim * 64.0f, &sn, &cs); Lr = e * cs; Li = e * sn; }
        float4* tp = (float4*)((float*)(PWS + WS_S5T) + (size_t)gid * 36);
        tp[0] = make_float4(lbr, lbi, Lr, Li);
#pragma unroll
        for (int q = 0; q < 4; ++q) { tp[1 + q] = make_float4(bre[4 * q], bre[4 * q + 1], bre[4 * q + 2], bre[4 * q + 3]); tp[5 + q] = make_float4(bim[4 * q], bim[4 * q + 1], bim[4 * q + 2], bim[4 * q + 3]); } }
}

__device__ __forceinline__ void s5_load(const float* tbl, int l, int g, int lane, float& lbr, float& lbi, float& Lr, float& Li, float (&bre)[16], float (&bim)[16]) {
    const float4* tp = (const float4*)(tbl + ((size_t)((l * 16 + g) * 64 + lane)) * 36);
    const float4 h = tp[0]; lbr = h.x; lbi = h.y; Lr = h.z; Li = h.w;
#pragma unroll
    for (int q = 0; q < 4; ++q) { const float4 a = tp[1 + q], c = tp[5 + q];
        bre[4 * q] = a.x; bre[4 * q + 1] = a.y; bre[4 * q + 2] = a.z; bre[4 * q + 3] = a.w; bim[4 * q] = c.x; bim[4 * q + 1] = c.y; bim[4 * q + 2] = c.z; bim[4 * q + 3] = c.w; }
}

__device__ __forceinline__ void ph_mixA(const KP& p, int l, float* lds) {
    ZDEF;
    const int tid = ltid(), wave = __builtin_amdgcn_readfirstlane(tid >> 6), lane = tid & 63;
    const int gw = blockIdx.x * NWV + wave, NGW = gridDim.x * NWV;
    const float* U = (const float*)(PWS + WS_A);
    const float* ROPE = (const float*)(PWS + WS_ROPE);
    {
        typedef float f32x4v __attribute__((ext_vector_type(4)));
        typedef short bf16x8c __attribute__((ext_vector_type(8)));
        float* red = lds;
        float* hid = lds + 8 * 2048;
        float* w2s = lds + 8 * 2048 + 2048;
        float* KC = (float*)(PWS + WS_KCMP); bf16* VTC = (bf16*)(PWS + WS_VTC);
        const bf16* W1C = (const bf16*)(PWS + WS_WCT);
        for (int item = blockIdx.x; item < 256; item += gridDim.x) {
            const int rt = item & 31, g = (item >> 5) & 1, kv = (item >> 6) & 1, b = item >> 7, n0 = 16 * rt;
            const int arow = lane & 15, kq = lane >> 4;
            const float* pe = PIN(16) + (size_t)l * 4096 + kv * 2048;
            const bf16* wb = W1C + (size_t)kv * 128 * 2048 + (size_t)arow * 2048 + 8 * kq;
            f32x4v acc[8];
#pragma unroll
            for (int ct = 0; ct < 8; ++ct) acc[ct] = (f32x4v){0.f, 0.f, 0.f, 0.f};
#pragma unroll 2
            for (int ksl = 0; ksl < 8; ++ksl) {
                const int k0 = 256 * wave + 32 * ksl + 8 * kq, jt = k0 >> 6, d = k0 & 63;
                const int tok = min(16 * (n0 + arow) + jt, SEQ - 1);
                const float4* up = (const float4*)(U + (size_t)(b * SEQ + tok) * NINP + C_KC + kv * 128 + g * 64 + d);
                const float4* pp = (const float4*)(pe + jt * 64 + d);
                const float4 u0 = up[0], u1 = up[1], p0 = pp[0], p1 = pp[1];
                union { unsigned u[4]; bf16x8c v; } af;
                af.u[0] = pk2(u0.x + p0.x, u0.y + p0.y); af.u[1] = pk2(u0.z + p0.z, u0.w + p0.w); af.u[2] = pk2(u1.x + p1.x, u1.y + p1.y); af.u[3] = pk2(u1.z + p1.z, u1.w + p1.w);
#pragma unroll
                for (int ct = 0; ct < 8; ++ct) { const bf16x8c bfr = *(const bf16x8c*)(wb + (size_t)ct * 16 * 2048 + 256 * wave + 32 * ksl);
                    acc[ct] = __builtin_amdgcn_mfma_f32_16x16x32_bf16(af.v, bfr, acc[ct], 0, 0, 0); }
            }
            __syncthreads();
            { const float4* w2g = (const float4*)((kv ? PIN(20) : PIN(18)) + (size_t)l * 128 * 64);
#pragma unroll
              for (int q = 0; q < 4; ++q) ((float4*)w2s)[tid + 512 * q] = w2g[tid + 512 * q]; }
#pragma unroll
            for (int ct = 0; ct < 8; ++ct)
#pragma unroll
                for (int i = 0; i < 4; ++i) red[(wave * 16 + 4 * kq + i) * 128 + 16 * ct + arow] = acc[ct][i];
            __syncthreads();
#pragma unroll
            for (int q = 0; q < 4; ++q) { const int o = tid + 512 * q; float s = 0.f;
#pragma unroll
                for (int w = 0; w < 8; ++w) s += red[w * 2048 + o];
                hid[o] = gelu_t(s); }
            __syncthreads();
            {
                const int d = lane;
                const float* w2 = w2s + d;
                float o0 = 0.f, o1 = 0.f;
                const float* h0 = hid + (2 * wave) * 128; const float* h1 = h0 + 128;
#pragma unroll 8
                for (int jj = 0; jj < 128; ++jj) { const float w = w2[jj * 64]; o0 += h0[jj] * w; o1 += h1[jj] * w; }
#pragma unroll
                for (int q = 0; q < 2; ++q) { const int n = n0 + 2 * wave + q; float o = q ? o1 : o0;
                    if (kv == 0) {
                        const float y = o * rsqrtf(wsum(o * o) * (1.0f / 64.0f) + EPSN) * PIN(15)[l * 192 + d];
                        const float pr = __shfl_xor(y, 8); const int pos = min(16 * n + 31, SEQ - 1);
                        const float cs = ROPE[pos * 16 + (d & 7)], sn = ROPE[pos * 16 + 8 + (d & 7)];
                        o = d < 8 ? y * cs - pr * sn : (d < 16 ? y * cs + pr * sn : y);
                    }
                    if (n >= 511) o = 0.f;
                    if (kv == 0) { const size_t ki = (size_t)(b * 2 + g) * 32768 + (size_t)(n >> 5) * 2048 + ((((d & 31) >> 3) * 64) + (n & 31) + 32 * (d >> 5)) * 8 + (d & 7);
                        const unsigned hb = f2bf(o); const float lo = o - __uint_as_float(hb << 16);
                        ((bf16*)KC)[ki] = (bf16)hb; ((bf16*)KC)[4 * 32768 + ki] = (bf16)f2bf(lo); }
                    else { const int kk = n & 31, rem = kk & 15, hh2 = (rem >> 2) & 1, e = 4 * (rem >> 3) + (rem & 3);
                        VTC[(size_t)(b * 2 + g) * 32768 + (size_t)(n >> 5) * 2048 + (((d >> 5) * 2 + (kk >> 4)) * 64 + (d & 31) + 32 * hh2) * 8 + e] = (bf16)f2bf(o); } }
            }
        }
        __syncthreads();
    }
    {
        float* ut = lds;
        float* pl = lds + 47 * 256;
        bf16* YMIX = (bf16*)(PWS + WS_XN);
        const int pr_ = lane & 31, ph_ = lane >> 5, pgi = wave >> 1, pdd = pgi * 64 + 32 * (wave & 1) + pr_;
        bf16x8v pwf[4];
#pragma unroll
        for (int ks = 0; ks < 4; ++ks) { const float* wp = PIN(11) + (size_t)l * 16384 + pgi * 4096 + (size_t)(16 * ks + 8 * ph_) * 64 + (pdd & 63);
            union { unsigned u[4]; bf16x8v v; } bf_;
#pragma unroll
            for (int q = 0; q < 4; ++q) bf_.u[q] = pk2(wp[(2 * q) * 64], wp[(2 * q + 1) * 64]);
            pwf[ks] = bf_.v; }
        const float pbv = PIN(12)[l * 256 + pdd], psc = PIN(13)[l * 256 + pdd];
        for (int item = blockIdx.x; item < 512; item += gridDim.x) {
            const int row0 = item * 32, b = row0 >> 13, t0 = row0 & (SEQ - 1);
            for (int i = tid; i < 47 * 64; i += NTHR) { const int r = i >> 6, c4 = i & 63, t = t0 - 15 + r;
                float4 v = make_float4(0.f, 0.f, 0.f, 0.f); if (t >= 0) v = *(const float4*)(U + (size_t)(b * SEQ + t) * NINP + 4 * c4);
                ((float4*)ut)[i] = v; }
            __syncthreads();
            for (int i = tid; i < 32 * 256; i += NTHR) { const int tt = i >> 8, ch = i & 255, gi = ch >> 6, w = 2 << gi, t = t0 + tt; const int cnt = min(t + 1, w);
                float s = 0.f; for (int q = 0; q < cnt; ++q) s += ut[(tt + 15 - q) * 256 + ch];
                pl[i] = s * __builtin_amdgcn_rcpf((float)cnt) - ut[(tt + 15) * 256 + ch]; }
            __syncthreads();
            {
                f32x16 acc;
#pragma unroll
                for (int i = 0; i < 16; ++i) acc[i] = 0.f;
#pragma unroll
                for (int ks = 0; ks < 4; ++ks) { const float* ap = pl + pr_ * 256 + pgi * 64 + 16 * ks + 8 * ph_;
                    const float4 f0 = *(const float4*)ap, f1 = *(const float4*)(ap + 4);
                    union { unsigned u[4]; bf16x8v v; } af; af.u[0] = pk2(f0.x, f0.y); af.u[1] = pk2(f0.z, f0.w); af.u[2] = pk2(f1.x, f1.y); af.u[3] = pk2(f1.z, f1.w);
                    acc = __builtin_amdgcn_mfma_f32_32x32x16_bf16(af.v, pwf[ks], acc, 0, 0, 0); }
                __syncthreads();
#pragma unroll
                for (int i = 0; i < 16; ++i) { const int rr = 8 * (i >> 2) + 4 * ph_ + (i & 3); ut[rr * 256 + pdd] = (acc[i] + pbv) * psc; }
            }
            __syncthreads();
#pragma unroll
            for (int q = 0; q < 4; ++q) { const int tt = 4 * wave + q; float v[4]; float ss = 0.f;
#pragma unroll
                for (int jx = 0; jx < 4; ++jx) { v[jx] = ut[tt * 256 + lane + 64 * jx]; ss += v[jx] * v[jx]; }
                const float rinv = rsqrtf(wsum(ss) * (1.0f / 256.0f) + EPSN);
#pragma unroll
                for (int jx = 0; jx < 4; ++jx) YMIX[(size_t)(row0 + tt) * DM + lane + 64 * jx] = (bf16)f2bf(v[jx] * rinv * PIN(10)[l * DM + lane + 64 * jx]); }
            __syncthreads();
        }
    }
    {
        bf16* VTS = (bf16*)(PWS + WS_VTS); bf16* VTW = (bf16*)(PWS + WS_VTW);
        const int rowid = tid >> 1, hh = tid & 1, kind = rowid >> 7, g = (rowid >> 6) & 1, d = rowid & 63;
        for (int item = blockIdx.x; item < 512; item += gridDim.x) {
            const int row0 = item * 32, b = row0 >> 13, k0 = row0 & (SEQ - 1);
            const float* up = U + (size_t)row0 * NINP + (kind ? C_VW : C_VS) + g * 64 + d;
            unsigned w[8];
#pragma unroll
            for (int s2 = 0; s2 < 2; ++s2)
#pragma unroll
                for (int jp = 0; jp < 4; ++jp) { const int j = 2 * jp; const int ka = 16 * s2 + 8 * (j >> 2) + 4 * hh + (j & 3);
                    w[s2 * 4 + jp] = pk2(up[(size_t)ka * NINP], up[(size_t)(ka + 1) * NINP]); }
            bf16* dst = (kind ? VTW : VTS) + (size_t)(b * 2 + g) * SEQ * 64 + (size_t)(k0 >> 5) * 2048 + (((d >> 5) * 2) * 64 + (d & 31) + 32 * hh) * 8;
            *(uint4*)dst = make_uint4(w[0], w[1], w[2], w[3]); *(uint4*)(dst + 512) = make_uint4(w[4], w[5], w[6], w[7]);
        }
    }
    {
        float* QN = (float*)(PWS + WS_QN); bf16* KS = (bf16*)(PWS + WS_KS); bf16* KW = (bf16*)(PWS + WS_KW);
        const float qg = PIN(14)[l * 64 + lane], ksg = PIN(15)[l * 192 + 64 + lane], kwg = PIN(15)[l * 192 + 128 + lane];
        for (int m0 = gw; m0 < MTOK; m0 += 2 * NGW) {
            float vv[2][12]; float csn[2][2];
#pragma unroll
            for (int e = 0; e < 2; ++e) { const int m = min(m0 + e * NGW, MTOK - 1), t = m & (SEQ - 1); const float* u = U + (size_t)m * NINP;
                csn[e][0] = ROPE[t * 16 + (lane & 7)]; csn[e][1] = ROPE[t * 16 + 8 + (lane & 7)];
#pragma unroll
                for (int h = 0; h < 12; ++h) vv[e][h] = u[h < 8 ? C_Q + h * 64 + lane : (h < 10 ? C_KS + (h - 8) * 64 + lane : C_KW + (h - 10) * 64 + lane)]; }
#pragma unroll
            for (int e = 0; e < 2; ++e) { const int m = m0 + e * NGW, t = m & (SEQ - 1); const float cs = csn[e][0], sn = csn[e][1];
                if (m >= MTOK) continue;
#pragma unroll
                for (int h = 0; h < 12; ++h) {
                    const float v = vv[e][h];
                    const float gn = h < 8 ? qg : (h < 10 ? ksg : kwg);
                    const float y = v * rsqrtf(wsum(v * v) * (1.0f / 64.0f) + EPSN) * gn;
                    const float pr = __int_as_float(__builtin_amdgcn_mov_dpp(__float_as_int(y), 0x128, 0xf, 0xf, true));
                    const float o = lane < 8 ? y * cs - pr * sn : (lane < 16 ? y * cs + pr * sn : y);
                    if (h < 8) QN[(size_t)m * 512 + h * 64 + lane] = o * 0.18033688011112042f;
                    else { const int gg = h & 1, bgi = (m >> 13) * 2 + gg;
                        const size_t di = (size_t)bgi * SEQ * 64 + (size_t)(t >> 5) * 2048 + ((((lane & 31) >> 3) * 64) + (t & 31) + 32 * (lane >> 5)) * 8 + (lane & 7);
                        (h < 10 ? KS : KW)[di] = (bf16)f2bf(o); }
                }
            }
        }
    }
    {
        float* SE = (float*)(PWS + WS_S5END);
        for (int it = gw; it < 4096; it += NGW) {
            const int c = it & 127, g = (it >> 7) & 15, b = it >> 11;
            float lbr, lbi, bre[16], bim[16], Lr_, Li_; s5_load((const float*)(PWS + WS_S5T), l, g, lane, lbr, lbi, Lr_, Li_, bre, bim);
            float xr = 0.f, xi = 0.f;
            const float* up = U + (size_t)(b * SEQ + c * 64) * NINP + C_S5 + g * 16;
            float* us = lds + wave * 1024;
            { const float4* ul = (const float4*)(up + (size_t)lane * NINP); const float4 a0 = ul[0], a1 = ul[1], a2 = ul[2], a3 = ul[3];
              float4* ud = (float4*)(us + lane * 16); ud[0] = a0; ud[1] = a1; ud[2] = a2; ud[3] = a3; }
            LDSW();
            for (int s = 0; s < 64; ++s) {
                const float4* u4 = (const float4*)(us + s * 16);
                float bur = 0.f, bui = 0.f;
#pragma unroll
                for (int q = 0; q < 4; ++q) { const float4 uv = u4[q];
                    bur += bre[4 * q] * uv.x + bre[4 * q + 1] * uv.y + bre[4 * q + 2] * uv.z + bre[4 * q + 3] * uv.w;
                    bui += bim[4 * q] * uv.x + bim[4 * q + 1] * uv.y + bim[4 * q + 2] * uv.z + bim[4 * q + 3] * uv.w; }
                const float nxr = lbr * xr - lbi * xi + bur, nxi = lbr * xi + lbi * xr + bui; xr = nxr; xi = nxi;
            }
            LDSW();
            *(float2*)(SE + ((size_t)((b * 16 + g) * 128 + c) * 64 + lane) * 2) = make_float2(xr, xi);
        }
    }
}

__device__ __forceinline__ unsigned cvtpk(float lo, float hi) { unsigned r; asm volatile("v_cvt_pk_bf16_f32 %0, %1, %2" : "=v"(r) : "v"(lo), "v"(hi)); return r; }
template <bool MASK> __device__ __forceinline__ void sm_update(f32x16& acc, int d1, int d2, float& m, float& ls, f32x16& o0, f32x16& o1, bf16x8v (&pb)[2]) {
    float tmax = -1e30f;
#pragma unroll
    for (int i = 0; i < 16; ++i) { if (MASK) { const int cst = (i & 3) + 8 * (i >> 2); acc[i] = (cst <= d1 && cst > d2) ? acc[i] : -1e30f; } tmax = fmaxf(tmax, acc[i]); }
    tmax = fmaxf(tmax, __shfl_xor(tmax, 32));
    const float mn = fmaxf(m, tmax), alpha = __builtin_amdgcn_exp2f(m - mn);
    float ps = 0.f;
#pragma unroll
    for (int i = 0; i < 16; ++i) { float pv = __builtin_amdgcn_exp2f(acc[i] - mn); if (MASK) pv = acc[i] > -1e29f ? pv : 0.f; acc[i] = pv; ps += pv; }
    ls = ls * alpha + ps; m = mn;
    o0 *= alpha; o1 *= alpha;
#pragma unroll
    for (int s = 0; s < 2; ++s) { union { unsigned u[4]; bf16x8v v; } pk;
#pragma unroll
        for (int q = 0; q < 4; ++q) pk.u[q] = cvtpk(acc[8 * s + 2 * q], acc[8 * s + 2 * q + 1]);
        pb[s] = pk.v; }
}
__device__ __forceinline__ void sm_update_fast(f32x16& acc, bool sel, float& m, float& ls, f32x16& o0, f32x16& o1, bf16x8v (&pb)[2]) {
    float tmax = acc[0];
#pragma unroll
    for (int i = 1; i < 16; ++i) tmax = fmaxf(tmax, acc[i]);
    tmax = sel ? tmax : -1e30f;
    if (__any(tmax > m + 8.0f)) {
        const float t2 = fmaxf(tmax, __shfl_xor(tmax, 32)), mn = fmaxf(m, t2), alpha = __builtin_amdgcn_exp2f(m - mn);
        ls *= alpha; o0 *= alpha; o1 *= alpha; m = mn;
    }
    float ps = 0.f;
#pragma unroll
    for (int i = 0; i < 16; ++i) { const float pv = __builtin_amdgcn_exp2f(acc[i] - m); acc[i] = pv; ps += pv; }
    ls += sel ? ps : 0.f;
#pragma unroll
    for (int s = 0; s < 2; ++s) { union { unsigned u[4]; bf16x8v v; } pk;
#pragma unroll
        for (int q = 0; q < 4; ++q) { const unsigned w = cvtpk(acc[8 * s + 2 * q], acc[8 * s + 2 * q + 1]); pk.u[q] = sel ? w : 0u; }
        pb[s] = pk.v; }
}

template <bool NT = false> __device__ __forceinline__ void nsa_load(const bf16* kbase, const bf16* vbase, int key0, bf16x8v (&kb)[4], bf16x8v (&va)[4], bool noload) {
#ifdef PROBE_NOLOAD
    if (noload) { const short sv = (short)key0;
#pragma unroll
        for (int ks = 0; ks < 4; ++ks) { kb[ks] = (bf16x8v){sv, sv, sv, sv, sv, sv, sv, sv}; va[ks] = kb[ks]; }
        return; }
#endif
    const bf16* kp = kbase + (size_t)(key0 >> 5) * 2048; const bf16* vp = vbase + (size_t)(key0 >> 5) * 2048;
#pragma unroll
    for (int ks = 0; ks < 4; ++ks) {
        if (NT) { kb[ks] = __builtin_nontemporal_load((const bf16x8v*)(kp + 512 * ks)); va[ks] = __builtin_nontemporal_load((const bf16x8v*)(vp + 512 * ks)); }
        else { kb[ks] = *(const bf16x8v*)(kp + 512 * ks); va[ks] = *(const bf16x8v*)(vp + 512 * ks); } }
}
__device__ __forceinline__ void nsa_compute(const bf16x8v (&kb)[4], const bf16x8v (&va)[4], const bf16x8v (&qb)[4], bool full, bool sel, int d1, int d2, float& m, float& ls, f32x16& o0, f32x16& o1) {
    f32x16 acc;
#pragma unroll
    for (int i = 0; i < 16; ++i) acc[i] = 0.f;
#pragma unroll
    for (int ks = 0; ks < 4; ++ks) acc = __builtin_amdgcn_mfma_f32_32x32x16_bf16(kb[ks], qb[ks], acc, 0, 0, 0);
    bf16x8v pb[2];
    if (full) sm_update_fast(acc, sel, m, ls, o0, o1, pb);
    else sm_update<true>(acc, d1, d2, m, ls, o0, o1, pb);
    o0 = __builtin_amdgcn_mfma_f32_32x32x16_bf16(va[0], pb[0], o0, 0, 0, 0); o0 = __builtin_amdgcn_mfma_f32_32x32x16_bf16(va[1], pb[1], o0, 0, 0, 0);
    o1 = __builtin_amdgcn_mfma_f32_32x32x16_bf16(va[2], pb[0], o1, 0, 0, 0); o1 = __builtin_amdgcn_mfma_f32_32x32x16_bf16(va[3], pb[1], o1, 0, 0, 0);
}

template <bool FIRST> __device__ __forceinline__ void nsa_out(float* op, const f32x16& o0, const f32x16& o1, float sc, bool dry) {
    if (dry) return;
#pragma unroll
    for (int a = 0; a < 4; ++a) {
        float4 v0 = make_float4(o0[4 * a] * sc, o0[4 * a + 1] * sc, o0[4 * a + 2] * sc, o0[4 * a + 3] * sc), v1 = make_float4(o1[4 * a] * sc, o1[4 * a + 1] * sc, o1[4 * a + 2] * sc, o1[4 * a + 3] * sc);
        if (!FIRST) { const float4 p0 = *(const float4*)(op + 8 * a), p1 = *(const float4*)(op + 32 + 8 * a); v0.x += p0.x; v0.y += p0.y; v0.z += p0.z; v0.w += p0.w; v1.x += p1.x; v1.y += p1.y; v1.z += p1.z; v1.w += p1.w; }
        *(float4*)(op + 8 * a) = v0; *(float4*)(op + 32 + 8 * a) = v1; }
}
__device__ __forceinline__ void ph_mixB(const KP& p, int l, float* lds, bool dry, int parts) {
    ZDEF;
    const int tid = ltid(), wave = __builtin_amdgcn_readfirstlane(tid >> 6), lane = tid & 63;
    const int vb = (gridDim.x % 8 == 0) ? (int)(blockIdx.x % 8) * (int)(gridDim.x / 8) + (int)(blockIdx.x / 8) : (int)blockIdx.x;
    const int gw = vb * NWV + wave, NGW = gridDim.x * NWV;
    const float* U = (const float*)(PWS + WS_A);
    float* QN = (float*)(PWS + WS_QN); const bf16* KSb = (const bf16*)(PWS + WS_KS); const bf16* KWb = (const bf16*)(PWS + WS_KW);
    const float* KC = (const float*)(PWS + WS_KCMP);
    const bf16* VTS = (const bf16*)(PWS + WS_VTS); const bf16* VTW = (const bf16*)(PWS + WS_VTW); const bf16* VTC = (const bf16*)(PWS + WS_VTC);
    float* wl = lds + wave * 2112;
    float* Gs = wl; float* Es = wl + 1024; unsigned long long* selm = (unsigned long long*)(wl + 2048);
#ifndef NO_NSA
    if (parts & 1)
    for (int uu = gw; uu < 2048; uu += NGW)
    for (int ui = 0; ui < 2; ++ui) {
        const int bg = uu >> 9, ti = ui == 0 ? (uu & 511) : 1023 - (uu & 511);
        const int b = bg >> 1, g = bg & 1, t0 = ti * 8;
        const int c = lane & 31, h = lane >> 5, ql = c >> 2, r = c & 3;
        const int t = t0 + ql;
        const size_t row = (size_t)b * SEQ + t;
        float qf[32];
        { const float4* qp = (const float4*)(QN + row * 512 + (g * 4 + r) * 64 + 32 * h);
#pragma unroll
          for (int i = 0; i < 8; ++i) { const float4 v = qp[i]; qf[4 * i] = v.x; qf[4 * i + 1] = v.y; qf[4 * i + 2] = v.z; qf[4 * i + 3] = v.w; } }
#pragma unroll
        for (int i = 0; i < 16; ++i) { Gs[64 * i + lane] = 0.f; Es[64 * i + lane] = 0.f; }
        const int nv = (t >= 31) ? ((t - 31) >> 4) + 1 : 0;
        const int nvmax = (t0 + 7 >= 31) ? ((t0 + 7 - 31) >> 4) + 1 : 0, ntile = (nvmax + 31) >> 5;
        const bf16* kcb = (const bf16*)KC + (size_t)bg * 32768 + lane * 8;
        bf16x8v qb[4], qbl[4];
#pragma unroll
        for (int ks = 0; ks < 4; ++ks) { union { unsigned u[4]; bf16x8v v; } ph_, pl_;
#pragma unroll
            for (int q = 0; q < 4; ++q) { const float a0 = qf[8 * ks + 2 * q], a1 = qf[8 * ks + 2 * q + 1]; const unsigned h0 = f2bf(a0), h1 = f2bf(a1);
                ph_.u[q] = h0 | (h1 << 16); pl_.u[q] = pk2(a0 - __uint_as_float(h0 << 16), a1 - __uint_as_float(h1 << 16)); }
            qb[ks] = ph_.v; qbl[ks] = pl_.v; }
        float mc = -1e30f, lc = 0.f;
        bf16x8v kfa[8];
#pragma unroll
        for (int i = 0; i < 4; ++i) { kfa[i] = *(const bf16x8v*)(kcb + 512 * i); kfa[4 + i] = *(const bf16x8v*)(kcb + 4 * 32768 + 512 * i); }
        for (int kt = 0; kt < ntile; ++kt) {
            f32x16 acc;
#pragma unroll
            for (int i = 0; i < 16; ++i) acc[i] = 0.f;
            const bf16* kpn = kcb + (size_t)min(kt + 1, ntile - 1) * 2048;
            bf16x8v kfb[8];
#pragma unroll
            for (int i = 0; i < 4; ++i) { kfb[i] = *(const bf16x8v*)(kpn + 512 * i); kfb[4 + i] = *(const bf16x8v*)(kpn + 4 * 32768 + 512 * i); }
#pragma unroll
            for (int ks = 0; ks < 4; ++ks) { acc = __builtin_amdgcn_mfma_f32_32x32x16_bf16(kfa[ks], qbl[ks], acc, 0, 0, 0); acc = __builtin_amdgcn_mfma_f32_32x32x16_bf16(kfa[4 + ks], qb[ks], acc, 0, 0, 0); }
#pragma unroll
            for (int ks = 0; ks < 4; ++ks) acc = __builtin_amdgcn_mfma_f32_32x32x16_bf16(kfa[ks], qb[ks], acc, 0, 0, 0);
#pragma unroll
            for (int i = 0; i < 8; ++i) kfa[i] = kfb[i];
            const int d1 = nv - 1 - (32 * kt + 4 * h);
            float tmax = -1e30f;
#pragma unroll
            for (int i = 0; i < 16; ++i) { const int cst = (i & 3) + 8 * (i >> 2); acc[i] = cst <= d1 ? acc[i] : -1e30f; tmax = fmaxf(tmax, acc[i]); }
            tmax = fmaxf(tmax, __shfl_xor(tmax, 32));
            const float mn = fmaxf(mc, tmax); float ps = 0.f;
#pragma unroll
            for (int i = 0; i < 16; ++i) ps += acc[i] > -1e29f ? __builtin_amdgcn_exp2f(acc[i] - mn) : 0.f;
            ps += __shfl_xor(ps, 32);
            lc = lc * __builtin_amdgcn_exp2f(mc - mn) + ps; mc = mn;
        }
        const float invc = lc > 0.f ? 1.0f / lc : 0.f;
        const float* gt = U + row * NINP + C_GATE + (g * 4 + r) * 3;
        float* outp = QN + row * 512 + (g * 4 + r) * 64 + 4 * h;
        {
            f32x16 oc0, oc1;
#pragma unroll
            for (int i = 0; i < 16; ++i) { oc0[i] = 0.f; oc1[i] = 0.f; }
            const bf16* vcb = VTC + (size_t)bg * 32768 + lane * 8;
#pragma unroll
            for (int i = 0; i < 4; ++i) { kfa[i] = *(const bf16x8v*)(kcb + 512 * i); kfa[4 + i] = *(const bf16x8v*)(kcb + 4 * 32768 + 512 * i); }
            for (int kt = 0; kt < ntile; ++kt) {
                f32x16 acc;
#pragma unroll
                for (int i = 0; i < 16; ++i) acc[i] = 0.f;
                const bf16* kpn = kcb + (size_t)min(kt + 1, ntile - 1) * 2048;
                bf16x8v kfb[8];
#pragma unroll
                for (int i = 0; i < 4; ++i) { kfb[i] = *(const bf16x8v*)(kpn + 512 * i); kfb[4 + i] = *(const bf16x8v*)(kpn + 4 * 32768 + 512 * i); }
                const bf16x8v va00 = *(const bf16x8v*)(vcb + 2048 * kt), va01 = *(const bf16x8v*)(vcb + 2048 * kt + 512);
                const bf16x8v va10 = *(const bf16x8v*)(vcb + 2048 * kt + 1024), va11 = *(const bf16x8v*)(vcb + 2048 * kt + 1536);
#pragma unroll
                for (int ks = 0; ks < 4; ++ks) { acc = __builtin_amdgcn_mfma_f32_32x32x16_bf16(kfa[ks], qbl[ks], acc, 0, 0, 0); acc = __builtin_amdgcn_mfma_f32_32x32x16_bf16(kfa[4 + ks], qb[ks], acc, 0, 0, 0); }
#pragma unroll
                for (int ks = 0; ks < 4; ++ks) acc = __builtin_amdgcn_mfma_f32_32x32x16_bf16(kfa[ks], qb[ks], acc, 0, 0, 0);
#pragma unroll
                for (int i = 0; i < 8; ++i) kfa[i] = kfb[i];
                const int d1 = nv - 1 - (32 * kt + 4 * h);
#pragma unroll
                for (int i = 0; i < 16; ++i) { const int cst = (i & 3) + 8 * (i >> 2); acc[i] = cst <= d1 ? __builtin_amdgcn_exp2f(acc[i] - mc) * invc : 0.f; }
#pragma unroll
                for (int a = 0; a < 4; ++a) { float G = (acc[4 * a] + acc[4 * a + 1]) + (acc[4 * a + 2] + acc[4 * a + 3]), E = acc[4 * a + 3];
                    G = qsum(G); E = qsum(E);
                    if (r == 0) { const int j = 8 * kt + 2 * a + h; Gs[ql * 128 + j] = G; Es[ql * 128 + j] = E; } }
                bf16x8v pb[2];
#pragma unroll
                for (int s = 0; s < 2; ++s) { union { unsigned u[4]; bf16x8v v; } pk;
#pragma unroll
                    for (int q = 0; q < 4; ++q) pk.u[q] = cvtpk(acc[8 * s + 2 * q], acc[8 * s + 2 * q + 1]);
                    pb[s] = pk.v; }
                oc0 = __builtin_amdgcn_mfma_f32_32x32x16_bf16(va00, pb[0], oc0, 0, 0, 0); oc0 = __builtin_amdgcn_mfma_f32_32x32x16_bf16(va01, pb[1], oc0, 0, 0, 0);
                oc1 = __builtin_amdgcn_mfma_f32_32x32x16_bf16(va10, pb[0], oc1, 0, 0, 0); oc1 = __builtin_amdgcn_mfma_f32_32x32x16_bf16(va11, pb[1], oc1, 0, 0, 0);
            }
            nsa_out<true>(outp, oc0, oc1, sigm(gt[0]), dry);
        }
        LDSW();
        for (int q2 = 0; q2 < 8; ++q2) {
            const int cur = (t0 + q2) >> 6;
            unsigned long long mlo = 0ull, mhi = 0ull;
            if (cur < 16) { mlo = (2ull << cur) - 1ull; }
            else {
                const float* Gq = Gs + q2 * 128; const float* Eq = Es + q2 * 128;
                float v0, v1;
                { const int j = lane; const float im = Gq[j] - 0.5f * Eq[j] + (j > 0 ? 0.5f * Eq[j - 1] : 0.f);
                  const bool forced = (j == 0) || (j == cur) || (j == cur - 1); v0 = (j <= cur) ? (forced ? -INFINITY : im) : -1e30f; }
                { const int j = lane + 64; const float im = Gq[j] - 0.5f * Eq[j] + 0.5f * Eq[j - 1];
                  const bool forced = (j == cur) || (j == cur - 1); v1 = (j <= cur) ? (forced ? -INFINITY : im) : -1e30f; }
                mlo = 1ull;
                if (cur < 64) mlo |= 1ull << cur; else mhi |= 1ull << (cur - 64);
                if (cur - 1 < 64) mlo |= 1ull << (cur - 1); else mhi |= 1ull << (cur - 1 - 64);
                for (int i = 0; i < 13; ++i) {
                    const float mxv = wave_max_dpp(fmaxf(v0, v1));
                    const unsigned long long b0 = __ballot(v0 == mxv);
                    if (b0 != 0ull) { const int ln = __ffsll((long long)b0) - 1; mlo |= 1ull << ln; if (lane == ln) v0 = -INFINITY; }
                    else { const unsigned long long b1 = __ballot(v1 == mxv); const int ln = __ffsll((long long)b1) - 1; mhi |= 1ull << ln; if (lane == ln) v1 = -INFINITY; }
                }
            }
            if (lane == 0) { selm[2 * q2] = mlo; selm[2 * q2 + 1] = mhi; }
        }
        LDSW();
        const unsigned long long mylo = selm[2 * ql], myhi = selm[2 * ql + 1];
        const int jmax = (t0 + 7) >> 6;
        {
            f32x16 o0, o1;
#pragma unroll
            for (int i = 0; i < 16; ++i) { o0[i] = 0.f; o1[i] = 0.f; }
            float m = -1e30f, ls = 0.f;
            const bf16* kbase = KSb + (size_t)bg * SEQ * 64 + lane * 8;
            const bf16* vbase = VTS + (size_t)bg * SEQ * 64 + lane * 8;
            const int smax = (t0 + 7) >> 5;
            bf16x8v kbA[4], vaA[4], kbB[4], vaB[4];
            nsa_load(kbase, vbase, 0, kbA, vaA, dry);
            for (int sj = 0; sj <= smax; sj += 2) {
                nsa_load(kbase, vbase, 32 * min(sj + 1, smax), kbB, vaB, dry);
                {
                    const int j = sj >> 1, key0 = 32 * sj;
                    const bool sel = (((j < 64 ? mylo : myhi) >> (j & 63)) & 1ull) != 0ull;
                    const unsigned long long sb = __ballot(sel);
                    if (sb != 0ull) nsa_compute(kbA, vaA, qb, key0 + 31 <= t0, sel, (sel ? t : -1) - (key0 + 4 * h), -1000000, m, ls, o0, o1);
                }
                nsa_load(kbase, vbase, 32 * min(sj + 2, smax), kbA, vaA, dry);
                if (sj + 1 <= smax) {
                    const int j = sj >> 1, key0 = 32 * (sj + 1);
                    const bool sel = (((j < 64 ? mylo : myhi) >> (j & 63)) & 1ull) != 0ull;
                    const unsigned long long sb = __ballot(sel);
                    if (sb != 0ull) nsa_compute(kbB, vaB, qb, key0 + 31 <= t0, sel, (sel ? t : -1) - (key0 + 4 * h), -1000000, m, ls, o0, o1);
                }
            }
            ls += __shfl_xor(ls, 32);
            nsa_out<false>(outp, o0, o1, sigm(gt[1]) / ls, dry);
        }
        {
            f32x16 o0, o1;
#pragma unroll
            for (int i = 0; i < 16; ++i) { o0[i] = 0.f; o1[i] = 0.f; }
            float m = -1e30f, ls = 0.f;
            const bf16* kbase = KWb + (size_t)bg * SEQ * 64 + lane * 8;
            const bf16* vbase = VTW + (size_t)bg * SEQ * 64 + lane * 8;
            const int s0 = max(t0 - 511, 0) >> 5, s1 = (t0 + 7) >> 5;
            bf16x8v kbA[4], vaA[4], kbB[4], vaB[4];
            nsa_load<true>(kbase, vbase, 32 * s0, kbA, vaA, dry);
            for (int sj = s0; sj <= s1; sj += 2) {
                nsa_load<true>(kbase, vbase, 32 * min(sj + 1, s1), kbB, vaB, dry);
                { const int key0 = 32 * sj;
                  nsa_compute(kbA, vaA, qb, (key0 + 31 <= t0) && (key0 > t0 + 7 - 512), true, t - (key0 + 4 * h), t - 512 - (key0 + 4 * h), m, ls, o0, o1); }
                nsa_load<true>(kbase, vbase, 32 * min(sj + 2, s1), kbA, vaA, dry);
                if (sj + 1 <= s1) { const int key0 = 32 * (sj + 1);
                  nsa_compute(kbB, vaB, qb, (key0 + 31 <= t0) && (key0 > t0 + 7 - 512), true, t - (key0 + 4 * h), t - 512 - (key0 + 4 * h), m, ls, o0, o1); }
            }
            ls += __shfl_xor(ls, 32);
            nsa_out<false>(outp, o0, o1, sigm(gt[2]) / ls, dry);
        }
    }
#endif
#ifndef NO_S5B
    if (parts & 2) {
        typedef float f32x4v __attribute__((ext_vector_type(4)));
        const float* SE = (const float*)(PWS + WS_S5END); float* YS5 = (float*)(PWS + WS_YS5);
        float* us = wl;
        unsigned char* xi_ = (unsigned char*)(wl + 1024);
        for (int it = gw; it < 4096; it += NGW) {
            const int c = it & 127, g = (it >> 7) & 15, b = it >> 11;
            float lbr, lbi, bre[16], bim[16], Lr, Li; s5_load((const float*)(PWS + WS_S5T), l, g, lane, lbr, lbi, Lr, Li, bre, bim);
            const int hcol = lane & 15, kq = lane >> 4;
            bf16x8v cb[4];
#pragma unroll
            for (int ks = 0; ks < 4; ++ks) { const size_t ci = ((size_t)((l * 16 + g) * 16 + hcol)) * 64 + 16 * ks + 4 * kq;
                const float4 cr = *(const float4*)(PIN(26) + ci), cm = *(const float4*)(PIN(27) + ci);
                union { unsigned u[4]; bf16x8v v; } pk; pk.u[0] = pk2(cr.x, -cm.x); pk.u[1] = pk2(cr.y, -cm.y); pk.u[2] = pk2(cr.z, -cm.z); pk.u[3] = pk2(cr.w, -cm.w); cb[ks] = pk.v; }
            float xr = 0.f, xi = 0.f;
            const float* sep = SE + ((size_t)(b * 16 + g) * 128 * 64 + lane) * 2;
            int j = 0;
            for (; j + 16 <= c; j += 16) { float2 eb[16];
#pragma unroll
                for (int q = 0; q < 16; ++q) eb[q] = *(const float2*)(sep + (size_t)(j + q) * 128);
#pragma unroll
                for (int q = 0; q < 16; ++q) { const float nxr = Lr * xr - Li * xi + eb[q].x, nxi = Lr * xi + Li * xr + eb[q].y; xr = nxr; xi = nxi; } }
            for (; j < c; ++j) { const float2 e = *(const float2*)(sep + (size_t)j * 128); const float nxr = Lr * xr - Li * xi + e.x, nxi = Lr * xi + Li * xr + e.y; xr = nxr; xi = nxi; }
            const float* up = U + (size_t)(b * SEQ + c * 64) * NINP + C_S5 + g * 16;
            const float dsk = PIN(28)[l * 256 + g * 16 + hcol];
            { const float4* ul = (const float4*)(up + (size_t)lane * NINP); const float4 a0 = ul[0], a1 = ul[1], a2 = ul[2], a3 = ul[3];
              float4* ud = (float4*)(us + lane * 16); ud[0] = a0; ud[1] = a1; ud[2] = a2; ud[3] = a3; }
            LDSW();
            for (int sc = 0; sc < 4; ++sc) {
#pragma unroll 4
                for (int s2 = 0; s2 < 16; ++s2) {
                    const float4* u4 = (const float4*)(us + (16 * sc + s2) * 16);
                    float bur = 0.f, bui = 0.f;
#pragma unroll
                    for (int q = 0; q < 4; ++q) { const float4 uv = u4[q];
                        bur += bre[4 * q] * uv.x + bre[4 * q + 1] * uv.y + bre[4 * q + 2] * uv.z + bre[4 * q + 3] * uv.w;
                        bui += bim[4 * q] * uv.x + bim[4 * q + 1] * uv.y + bim[4 * q + 2] * uv.z + bim[4 * q + 3] * uv.w; }
                    const float nxr = lbr * xr - lbi * xi + bur, nxi = lbr * xi + lbi * xr + bui; xr = nxr; xi = nxi;
                    *(unsigned*)(xi_ + s2 * 272 + 4 * lane) = cvtpk(xr, xi);
                }
                LDSW();
                f32x4v acc = (f32x4v){0.f, 0.f, 0.f, 0.f};
#pragma unroll
                for (int ks = 0; ks < 4; ++ks) { const bf16x8v af = *(const bf16x8v*)(xi_ + hcol * 272 + (32 * ks + 8 * kq) * 2);
                    acc = __builtin_amdgcn_mfma_f32_16x16x32_bf16(af, cb[ks], acc, 0, 0, 0); }
#pragma unroll
                for (int i = 0; i < 4; ++i) { const int srow = 16 * sc + 4 * kq + i;
                    const float y = gelu_t(acc[i] + dsk * us[srow * 16 + hcol]);
                    YS5[(size_t)(b * SEQ + c * 64 + srow) * 256 + g * 16 + hcol] = y; }
                LDSW();
            }
        }
    }
#endif
}

__device__ __forceinline__ void ph_post(const KP& p, int l, float* lds) {
    ZDEF;
    const int tid = ltid(), wave = __builtin_amdgcn_readfirstlane(tid >> 6), lane = tid & 63;
    const float* ON = (const float*)(PWS + WS_QN); const float* YS5 = (const float*)(PWS + WS_YS5);
    bf16* YMIX = (bf16*)(PWS + WS_XN);
    const float* onorm = PIN(10) + (size_t)l * DM;
    float* ys = lds; float* ob = lds + 32 * 260;
    bf16x8v gfr[16];
    { const bf16* gp = (const bf16*)(PWS + WS_GLUT) + (size_t)(32 * wave + (lane & 31)) * 256 + 8 * (lane >> 5);
#pragma unroll
      for (int ks = 0; ks < 16; ++ks) gfr[ks] = *(const bf16x8v*)(gp + 16 * ks); }
    for (int item = blockIdx.x; item < 512; item += gridDim.x) {
        const int row0 = item * 32;
#pragma unroll
        for (int q = 0; q < 4; ++q) { const size_t row = row0 + 4 * wave + q; const float4* op = (const float4*)(ON + row * 512);
            const float4 v0 = op[lane], v1 = op[64 + lane];
            const float ss = (v0.x * v0.x + v0.y * v0.y) + (v0.z * v0.z + v0.w * v0.w) + (v1.x * v1.x + v1.y * v1.y) + (v1.z * v1.z + v1.w * v1.w);
            const float rinv = rsqrtf(wsum(ss) * (1.0f / 512.0f) + EPSN);
            const float4 g0 = *(const float4*)(onorm + 256 + 4 * lane), g1 = *(const float4*)(onorm + 512 + 4 * lane);
            uint2 o0, o1; o0.x = pk2(v0.x * rinv * g0.x, v0.y * rinv * g0.y); o0.y = pk2(v0.z * rinv * g0.z, v0.w * rinv * g0.w);
            o1.x = pk2(v1.x * rinv * g1.x, v1.y * rinv * g1.y); o1.y = pk2(v1.z * rinv * g1.z, v1.w * rinv * g1.w);
            *(uint2*)(YMIX + row * DM + 256 + 4 * lane) = o0; *(uint2*)(YMIX + row * DM + 512 + 4 * lane) = o1; }
        for (int i = tid; i < 32 * 64; i += NTHR) { const int rr = i >> 6, c4 = i & 63; *(float4*)(ys + rr * 260 + 4 * c4) = ((const float4*)(YS5 + (size_t)row0 * 256))[i]; }
        __syncthreads();
        {
            const int ar = lane & 31, ah = lane >> 5;
            f32x16 acc;
#pragma unroll
            for (int i = 0; i < 16; ++i) acc[i] = 0.f;
#pragma unroll
            for (int ks = 0; ks < 16; ++ks) { const float4 f0 = *(const float4*)(ys + ar * 260 + 16 * ks + 8 * ah), f1 = *(const float4*)(ys + ar * 260 + 16 * ks + 8 * ah + 4);
                union { unsigned u[4]; bf16x8v v; } af; af.u[0] = pk2(f0.x, f0.y); af.u[1] = pk2(f0.z, f0.w); af.u[2] = pk2(f1.x, f1.y); af.u[3] = pk2(f1.z, f1.w);
                acc = __builtin_amdgcn_mfma_f32_32x32x16_bf16(af.v, gfr[ks], acc, 0, 0, 0); }
            const int n = 32 * wave + ar; const float gb = PIN(30)[l * 256 + n];
#pragma unroll
            for (int i = 0; i < 16; ++i) { const int rr = 8 * (i >> 2) + 4 * ah + (i & 3); const float yv = ys[rr * 260 + n]; ob[rr * 256 + n] = yv * sigm(acc[i] + gb); }
        }
        __syncthreads();
#pragma unroll
        for (int q = 0; q < 4; ++q) { const int tt = 4 * wave + q; float v[4]; float ss = 0.f;
#pragma unroll
            for (int jx = 0; jx < 4; ++jx) { v[jx] = ob[tt * 256 + lane + 64 * jx]; ss += v[jx] * v[jx]; }
            const float rinv = rsqrtf(wsum(ss) * (1.0f / 256.0f) + EPSN);
#pragma unroll
            for (int jx = 0; jx < 4; ++jx) YMIX[(size_t)(row0 + tt) * DM + 768 + lane + 64 * jx] = (bf16)f2bf(v[jx] * rinv * onorm[768 + lane + 64 * jx]); }
        __syncthreads();
    }
}


#define LAS __attribute__((address_space(3)))
#define XB_TMO      128
#define XB_XCNT(j)  (256  + 64 * (j))
#define XB_XSUB(j)  (1280 + 64 * (j))
#define XB_XGEN(j)  (2304 + 64 * (j))
#define XB_TOP      3328
#define XB_TOPGEN   3392
#define XCD_BAR_WORDS 3456
#define XB_SPIN_CAP (1u << 18)

__device__ __forceinline__ unsigned xb_ld(unsigned* p)              { return __hip_atomic_load(p, __ATOMIC_RELAXED, __HIP_MEMORY_SCOPE_AGENT); }
__device__ __forceinline__ unsigned xb_add(unsigned* p, unsigned v) { return __hip_atomic_fetch_add(p, v, __ATOMIC_RELAXED, __HIP_MEMORY_SCOPE_AGENT); }
__device__ __forceinline__ unsigned xb_xcc_id() { return (unsigned)__builtin_amdgcn_s_getreg((3 << 11) | 20) & 0xFu; }
#define XB_SPIN(cond, bar) do { unsigned _sp = 0; while (cond) { __builtin_amdgcn_s_sleep(1); \
    if ((++_sp & 255u) == 0u) { if (xb_ld(&(bar)[XB_TMO])) break; if (_sp > XB_SPIN_CAP) { atomicAdd(&(bar)[XB_TMO], 1u); break; } } } } while (0)

struct XcdBarrier {
    unsigned* bar; unsigned x;
    volatile LAS unsigned* st;
};

__device__ __forceinline__ XcdBarrier xcd_barrier_post(unsigned* bar, volatile LAS unsigned* st) {
    XcdBarrier b; b.bar = bar; b.x = xb_xcc_id(); b.st = st;
    if (threadIdx.x == 0) (void)xb_add(&bar[XB_XCNT(b.x)], 1u);
    return b;
}
__device__ __forceinline__ void xcd_barrier_complete(unsigned* bar, unsigned x, unsigned& nloc, unsigned& nx) {
    const unsigned G = gridDim.x * gridDim.y * gridDim.z;
    unsigned sum, cnt, mine, sp = 0u;
    for (;;) {
        sum = 0u; cnt = 0u; mine = 0u;
#pragma unroll
        for (unsigned j = 0; j < 16; ++j) { const unsigned c = xb_ld(&bar[XB_XCNT(j)]); sum += c; cnt += (c > 0u) ? 1u : 0u; mine = (j == x) ? c : mine; }
        if (sum == G) break;
        __builtin_amdgcn_s_sleep(1);
        if ((++sp & 255u) == 0u) { if (xb_ld(&bar[XB_TMO])) break; if (sp > XB_SPIN_CAP) { atomicAdd(&bar[XB_TMO], 1u); break; } }
    }
    nloc = mine > 0u ? mine : 1u; nx = cnt > 0u ? cnt : 1u;
}

__device__ __forceinline__ void xcd_barrier(const XcdBarrier& b) {
    asm volatile("s_waitcnt vmcnt(0)" ::: "memory");
    __syncthreads();
    if (threadIdx.x == 0) {
        unsigned* bar = b.bar;
        __builtin_amdgcn_s_waitcnt(0);
        unsigned nloc = b.st[0], nx = b.st[1];
        if (nloc == 0u) { xcd_barrier_complete(bar, b.x, nloc, nx); b.st[0] = nloc; b.st[1] = nx; }
        const unsigned old = xb_add(&bar[XB_XSUB(b.x)], 1u);
        const unsigned gen = old / nloc;
        if (old + 1u == (gen + 1u) * nloc) {
            __builtin_amdgcn_fence(__ATOMIC_RELEASE, "agent");
            asm volatile("s_waitcnt vmcnt(0)" ::: "memory");
            const unsigned og = xb_add(&bar[XB_TOP], 1u);
            const unsigned tg = og / nx;
            if (og + 1u == (tg + 1u) * nx) xb_add(&bar[XB_TOPGEN], 1u);
            else XB_SPIN(xb_ld(&bar[XB_TOPGEN]) == tg, bar);
            __builtin_amdgcn_fence(__ATOMIC_ACQUIRE, "agent");
            xb_add(&bar[XB_XGEN(b.x)], 1u);
            asm volatile("s_waitcnt vmcnt(0)" ::: "memory");
        } else {
            XB_SPIN(xb_ld(&bar[XB_XGEN(b.x)]) == gen, bar);
            __builtin_amdgcn_fence(__ATOMIC_ACQUIRE, "agent");
            asm volatile("s_waitcnt vmcnt(0)" ::: "memory");
        }
    }
    __syncthreads();
}
constexpr int NPHASE = 25;
#ifndef EN_MASK
#define EN_MASK 0xff
#endif
__global__ void __launch_bounds__(NTHR, 2) mk_fwd(KP p) {
    extern __shared__ __attribute__((aligned(16))) unsigned char smem[];
    cg::grid_group grid = cg::this_grid();
    float* ldsf = (float*)smem;
    PG8_LAS unsigned char* ldsl = (PG8_LAS unsigned char*)smem;
    volatile LAS unsigned* bst = (volatile LAS unsigned*)((LAS unsigned char*)smem + (LDS_BYTES - 128));
    if (threadIdx.x < 2) bst[threadIdx.x] = 0u;
    __syncthreads();
    XcdBarrier xbar = xcd_barrier_post((unsigned*)((unsigned char*)p.in[35] + WS_CTL), bst);
    for (int ph = p.ph_lo; ph < p.ph_hi; ++ph) {
        ZDEF;
        const float* modall = (const float*)(PWS + WS_MOD);
        bf16* XN = (bf16*)(PWS + WS_XN);
        int reps = 1;
#ifdef REPEAT_MASK
        { const int s_ = ph == 0 ? -1 : (ph - 1) % 12;
          const int bit = ph == 0 ? 1 : s_ == 0 ? 2 : (s_ == 3 || s_ == 9) ? 4 : s_ == 5 ? 8 : s_ == 6 ? 16 : s_ == 7 ? 32 : (s_ == 1 || s_ == 10) ? 64 : s_ == 4 ? 128 : 0;
          if (REPEAT_MASK & bit) reps = 2; }
#endif
        for (int rep = 0; rep < reps; ++rep) {
        const bool dry = (rep + 1 < reps);
        if (ph == 0) { if (EN_MASK & 1) ph_mod_rope(p, ldsf); ph_s5_table(p); }
        else {
            const int l = (ph - 1) / 12, s = (ph - 1) % 12;
            const float* modl = modall + (size_t)l * 2 * NMOD;
            const float* xin = (l == 0 && s <= 2) ? PIN(0) : POUT;
            if (s == 0) { if (EN_MASK & 2) ph_convert(p, l, ldsf); ph_norm(xin, PIN(4) + l * DM, modl, 0, XN); }
            else if (s == 3) { ph_norm(POUT, PIN(7) + l * DM, modl, 3, XN); }
            else if (s == 9) { ph_norm(POUT, PIN(31) + l * DM, modl, 6, XN); }
            else if ((EN_MASK & 4) && (s == 1 || s == 10)) {
                const int f = s == 1 ? 0 : 1;
                pg8::Gemm g{XN, (const bf16*)(PWS + WS_W1T) + (size_t)f * 2 * DFF * DM, MTOK, 2 * DFF, DM}; pg8::StaticOrder S; S.init(MTOK, 2 * DFF, gridDim.x, blockIdx.x);
                pg8::EpiSwiGLU E{(bf16*)(PWS + WS_A), DFF};
                pg8::gemm_phase<pg8::EpiSwiGLU, pg8::StaticOrder, true, true>(ldsl, g, S, E);
            }
            else if ((EN_MASK & 64) && (s == 2 || s == 11 || s == 8)) {
                const bf16* A = s == 8 ? (const bf16*)XN : (const bf16*)(PWS + WS_A);
                const bf16* Bt = s == 8 ? (const bf16*)(PWS + WS_WOUTT) : (const bf16*)(PWS + WS_W2T) + (size_t)(s == 2 ? 0 : 1) * DM * DFF;
                const int K = s == 8 ? DM : DFF;
                const int gi = s == 2 ? 2 : (s == 8 ? 5 : 8);
                pg8::Gemm g{A, Bt, MTOK, DM, K}; pg8::StaticOrder S; S.init(MTOK, DM, gridDim.x, blockIdx.x);
                pg8::EpiResid E{xin, POUT, modl + gi * DM, NMOD, s == 8 ? 1.0f : 0.5f, DM};
                pg8::gemm_phase<pg8::EpiResid, pg8::StaticOrder, true, true>(ldsl, g, S, E);
            }
            else if ((EN_MASK & 128) && s == 4) {
                pg8::Gemm g{XN, (const bf16*)(PWS + WS_WINT), MTOK, NINP, DM}; pg8::StaticOrder S; S.init(MTOK, NINP, gridDim.x, blockIdx.x);
                pg8::EpiF32 E{(float*)(PWS + WS_A), NINP};
                pg8::gemm_phase<pg8::EpiF32, pg8::StaticOrder, true, true>(ldsl, g, S, E);
            }
            else if ((EN_MASK & 8) && s == 5) { ph_mixA(p, l, ldsf); }
            else if ((EN_MASK & 16) && s == 6) {
#ifdef MIXB_DRY_PARTS
                ph_mixB(p, l, ldsf, dry, dry ? MIXB_DRY_PARTS : 3);
#else
                ph_mixB(p, l, ldsf, dry, 3);
#endif
            }
            else if ((EN_MASK & 32) && s == 7) { ph_post(p, l, ldsf); }
        }
        if (rep + 1 < reps) grid.sync();
        }
        if (ph + 1 < p.ph_hi) { if (ph == p.ph_lo) grid.sync(); else xcd_barrier(xbar); }
    }
}

extern "C" void kernel_launch(void* const* d_in, const int* in_sizes, int n_in, void* d_out, int out_size, void* d_ws, size_t ws_size, hipStream_t stream) {
    static int grid = 0;
    if (grid == 0) {
        if (n_in != 34 || out_size != MTOK * DM || ws_size < WS_END) { fprintf(stderr, "kernel_launch: unexpected shapes (n_in %d out %d ws %zu)\n", n_in, out_size, ws_size); grid = -1; return; }
        int dev = 0, cus = 0, per_cu = 0;
        hipGetDevice(&dev); hipDeviceGetAttribute(&cus, hipDeviceAttributeMultiprocessorCount, dev);
        if (hipFuncSetAttribute((const void*)mk_fwd, hipFuncAttributeMaxDynamicSharedMemorySize, LDS_BYTES) != hipSuccess) { fprintf(stderr, "kernel_launch: hipFuncSetAttribute failed\n"); }
        if (hipOccupancyMaxActiveBlocksPerMultiprocessor(&per_cu, (const void*)mk_fwd, NTHR, LDS_BYTES) != hipSuccess || per_cu < 1) { fprintf(stderr, "kernel_launch: occupancy query says %d\n", per_cu); per_cu = 1; }
        (void)hipGetLastError();
        grid = cus * 1;
        if (grid <= 0) grid = 256;
    }
    if (grid < 0) return;
    KP a{};
    for (int i = 0; i < 34; ++i) a.in[i] = (const float*)d_in[i];
    a.in[34] = (const float*)d_out; a.in[35] = (const float*)d_ws;
#if MK_MULTI
    for (int ph = 0; ph < NPHASE; ++ph) { a.ph_lo = ph; a.ph_hi = ph + 1; hipLaunchKernelGGL(mk_fwd, dim3(grid), dim3(NTHR), LDS_BYTES, stream, a); }
#else
    a.ph_lo = 0; a.ph_hi = NPHASE;
    if (hipMemsetAsync((unsigned char*)d_ws + WS_CTL, 0, CTL_BYTES, stream) != hipSuccess) fprintf(stderr, "kernel_launch: memset failed\n");
    void* args[] = {&a};
    hipError_t e = hipLaunchCooperativeKernel((const void*)mk_fwd, dim3(grid), dim3(NTHR), args, LDS_BYTES, stream);
    if (e != hipSuccess) fprintf(stderr, "kernel_launch: cooperative launch failed: %s (grid %d)\n", hipGetErrorString(e), grid);
#endif
}
```

```cpp
#include <hip/hip_runtime.h>
#include <hip/hip_cooperative_groups.h>
#include <cstdio>
#include <cstdint>
#include <cmath>
namespace pg8 {
#define PG8_LAS __attribute__((address_space(3)))
typedef unsigned short bf16_t;
typedef short bf16x8 __attribute__((ext_vector_type(8)));
typedef float f32x4 __attribute__((ext_vector_type(4)));
typedef unsigned u32x4 __attribute__((ext_vector_type(4)));
constexpr int BM = 256, BK = 64, HALF = 128, HTB = HALF * BK * 2  , STAGE_BYTES = 8 * HTB, NXCD = 8, WGM = 8;

__host__ __device__ __forceinline__ int lds_byte(int r, int c) { const int st = (r >> 4) * 2 + (c >> 5), rr = r & 15, cc = c & 31, ob = rr * 64 + cc * 2; return st * 1024 + (ob ^ (((ob >> 9) & 1) << 5)); }
__host__ __device__ __forceinline__ void stage_rc(int b, int& R, int& C) { const int st = b / 1024, sb = b % 1024, swz = sb ^ (((sb >> 9) & 1) << 5); R = (st >> 1) * 16 + swz / 64; C = (st & 1) * 32 + (swz % 64) / 2; }
__host__ __device__ __forceinline__ int perm32(int rho) { const int n = rho >> 4, i = rho & 15; return 8 * (i >> 2) + 4 * n + (i & 3); }

struct Unit { int pm, pn; };
struct Gemm { const bf16_t* A; const bf16_t* Bt; int M, N, K; };

struct StaticOrder {
    int nM, nN, nwg, G, c;
    __host__ __device__ void init(int M, int N, int G_, int c_) { nM = M / BM; nN = N / BM; nwg = nM * nN; G = G_; c = c_; }
    __host__ __device__ bool next(int i, Unit& u) const {
        const long L = (long)i * G + c; if (L >= nwg) return false;
        int wgid = (int)L; { const int q = nwg / NXCD, r = nwg % NXCD, xcd = wgid % NXCD, off = wgid / NXCD; wgid = (xcd < r ? xcd * (q + 1) : r * (q + 1) + (xcd - r) * q) + off; }
        const int nig = WGM * nN, gid = wgid / nig, fm = gid * WGM, gsz = (nM - fm) < WGM ? (nM - fm) : WGM;
        u.pm = fm + ((wgid % nig) % gsz); u.pn = (wgid % nig) / gsz; return true;
    }
    __device__ __forceinline__ void a_ready(const Unit&) const {}
    __device__ __forceinline__ void done(const Unit&) const {}
};

__device__ __forceinline__ unsigned cvt_pk_bf16(float lo, float hi) { unsigned r; asm volatile("v_cvt_pk_bf16_f32 %0, %1, %2" : "=v"(r) : "v"(lo), "v"(hi)); return r; }
typedef float f32x2 __attribute__((ext_vector_type(2)));
struct EpiSwiGLU {
    static constexpr bool PERM = true, AFTER_DRAIN = false;
    bf16_t* H; int ldh;
    __device__ __forceinline__ void operator()(const f32x4 (&acc)[2][2][4][2], const Unit& u, int wr, int wc, int fr, int fq) const {
        const int row0 = u.pm * BM + wr * 64 + fr; const int col0 = u.pn * HALF + wc * 32 + 8 * fq;
#pragma unroll
        for (int ai = 0; ai < 2; ++ai)
#pragma unroll
            for (int m = 0; m < 4; ++m) { bf16_t* rowp = H + (size_t)(row0 + ai * HALF + m * 16) * ldh + col0;
                float h[8];
#pragma unroll
                for (int n = 0; n < 2; ++n)
#pragma unroll
                    for (int i = 0; i < 4; ++i) { const float g = acc[ai][0][m][n][i], up = acc[ai][1][m][n][i]; h[4 * n + i] = g * up * __builtin_amdgcn_rcpf(1.0f + __expf(-g)); }
                u32x4 w; w.x = cvt_pk_bf16(h[0], h[1]); w.y = cvt_pk_bf16(h[2], h[3]); w.z = cvt_pk_bf16(h[4], h[5]); w.w = cvt_pk_bf16(h[6], h[7]);
                *(u32x4*)rowp = w; }
    }
};
struct EpiResid {
    static constexpr bool PERM = false, AFTER_DRAIN = false;
    const float* base; float* out; const float* gate; int gstride; float coef; int ldc;
    __device__ __forceinline__ void operator()(const f32x4 (&acc)[2][2][4][2], const Unit& u, int wr, int wc, int fr, int fq) const {
        const int b = (u.pm * BM) >> 13; const float* gp = gate + (size_t)b * gstride;
        const int col0 = u.pn * BM + wc * 32 + 4 * fq;
        f32x4 gv[2][2];
#pragma unroll
        for (int bj = 0; bj < 2; ++bj)
#pragma unroll
            for (int n = 0; n < 2; ++n) gv[bj][n] = *(const f32x4*)(gp + col0 + bj * HALF + n * 16) * coef;
#pragma unroll
        for (int ai = 0; ai < 2; ++ai)
#pragma unroll
            for (int m = 0; m < 4; ++m) { const size_t off = (size_t)(u.pm * BM + ai * HALF + wr * 64 + m * 16 + fr) * ldc + col0;
#pragma unroll
                for (int bj = 0; bj < 2; ++bj)
#pragma unroll
                    for (int n = 0; n < 2; ++n) { const f32x4 bs = *(const f32x4*)(base + off + bj * HALF + n * 16);
                        *(f32x4*)(out + off + bj * HALF + n * 16) = bs + gv[bj][n] * acc[ai][bj][m][n]; }
                asm volatile("" ::: "memory"); }
    }
};
struct EpiF32 {
    static constexpr bool PERM = false, AFTER_DRAIN = false;
    float* O; int ldc;
    __device__ __forceinline__ void operator()(const f32x4 (&acc)[2][2][4][2], const Unit& u, int wr, int wc, int fr, int fq) const {
        const int col0 = u.pn * BM + wc * 32 + 4 * fq;
#pragma unroll
        for (int ai = 0; ai < 2; ++ai)
#pragma unroll
            for (int m = 0; m < 4; ++m) { const size_t off = (size_t)(u.pm * BM + ai * HALF + wr * 64 + m * 16 + fr) * ldc + col0;
#pragma unroll
                for (int bj = 0; bj < 2; ++bj)
#pragma unroll
                    for (int n = 0; n < 2; ++n) *(f32x4*)(O + off + bj * HALF + n * 16) = acc[ai][bj][m][n];
                asm volatile("" ::: "memory"); }
    }
};
template <class Epi, class Sched, bool ALIGN_EPI = false, bool SP2 = false>
__device__ __forceinline__ void gemm_phase(PG8_LAS unsigned char* lds, const Gemm g, const Sched& S, const Epi& E) {
    int tid_ = threadIdx.x; asm volatile("" : "+v"(tid_)); const int tid = tid_, wid = __builtin_amdgcn_readfirstlane(tid >> 6), lane = tid & 63, wr = wid >> 2, wc = wid & 3, fr = lane & 15, fq = lane >> 4;
    const int K = g.K, nt = K / BK;
    unsigned voffA[2], voffB[2];
#pragma unroll
    for (int i = 0; i < 2; ++i) { int R, C; stage_rc(tid * 16 + i * 8192, R, C); const int Rb = Epi::PERM ? ((R & ~31) + perm32(R & 31)) : R;
        voffA[i] = (unsigned)(R * K + C) * 2u; voffB[i] = (unsigned)(Rb * K + C) * 2u; }
    const size_t kstep = (size_t)(BK * 2);
    const size_t hstep = (size_t)HALF * K * 2;
    const size_t tstep = 2 * hstep;
    const unsigned ldsw = (unsigned)wid * 1024u;
    const int aoff = lds_byte(wr * 64 + fr, fq * 8), boff = lds_byte(wc * 32 + fr, fq * 8);
#define PG8_SA(b, h) (((b) * 2 + (h)) * HTB)
#define PG8_SB(b, h) ((4 + (b) * 2 + (h)) * HTB)
#define PG8_STAGE(bufoff, gbase, voff) do { _Pragma("unroll") for (int _i = 0; _i < 2; ++_i) \
        __builtin_amdgcn_global_load_lds((const unsigned*)((const char*)(gbase) + (voff)[_i]), (PG8_LAS unsigned*)(lds + (bufoff) + ldsw + _i * 8192), 16, 0, 0); } while (0)
#define PG8_LDA(dst, b, h) do { _Pragma("unroll") for (int m = 0; m < 4; ++m) _Pragma("unroll") for (int k = 0; k < 2; ++k) dst[m][k] = *(const PG8_LAS bf16x8*)(lds + PG8_SA(b, h) + aoff + m * 2048 + k * 1024); } while (0)
#define PG8_LDB(dst, b, h) do { _Pragma("unroll") for (int n = 0; n < 2; ++n) _Pragma("unroll") for (int k = 0; k < 2; ++k) dst[n][k] = *(const PG8_LAS bf16x8*)(lds + PG8_SB(b, h) + boff + n * 2048 + k * 1024); } while (0)
#define PG8_MMA(ai, bj, At, Bt) do { __builtin_amdgcn_s_setprio(1); _Pragma("unroll") for (int m = 0; m < 4; ++m) _Pragma("unroll") for (int n = 0; n < 2; ++n) _Pragma("unroll") for (int k = 0; k < 2; ++k) \
        acc[ai][bj][m][n] = __builtin_amdgcn_mfma_f32_16x16x32_bf16(Bt[n][k], At[m][k], acc[ai][bj][m][n], 0, 0, 0); __builtin_amdgcn_s_setprio(0); } while (0)
#define PG8_WAIT_V(n) asm volatile("s_waitcnt vmcnt(" #n ")" ::: "memory")
#define PG8_WAIT_L(n) asm volatile("s_waitcnt lgkmcnt(" #n ")" ::: "memory")
#define PG8_BAR __builtin_amdgcn_s_barrier()
#define PG8_SCHED __builtin_amdgcn_sched_barrier(0)
    Unit cur, nxt; int ui = 0;
    if (!S.next(0, cur)) return;
    f32x4 acc[2][2][4][2];
#pragma unroll
    for (int a = 0; a < 2; ++a)
#pragma unroll
        for (int b = 0; b < 2; ++b)
#pragma unroll
            for (int m = 0; m < 4; ++m)
#pragma unroll
                for (int n = 0; n < 2; ++n) acc[a][b][m][n] = (f32x4){0.f, 0.f, 0.f, 0.f};
    bf16x8 At[4][2], B0[2][2], B1[2][2];
    const char* cA = (const char*)g.A + (size_t)cur.pm * tstep; const char* cB = (const char*)g.Bt + (size_t)cur.pn * tstep;
    S.a_ready(cur);
    if constexpr (SP2) {
        PG8_STAGE(PG8_SB(0, 0), cB, voffB); PG8_STAGE(PG8_SB(0, 1), cB + hstep, voffB); PG8_STAGE(PG8_SA(0, 0), cA, voffA); PG8_STAGE(PG8_SA(0, 1), cA + hstep, voffA);
        if (wr == 1) PG8_BAR;
        PG8_WAIT_V(2); PG8_BAR;
        PG8_STAGE(PG8_SB(1, 0), cB + kstep, voffB); PG8_STAGE(PG8_SA(1, 0), cA + kstep, voffA); PG8_STAGE(PG8_SB(1, 1), cB + hstep + kstep, voffB);
        PG8_WAIT_V(6); PG8_BAR;
    } else {
        PG8_STAGE(PG8_SB(0, 0), cB, voffB); PG8_STAGE(PG8_SA(0, 0), cA, voffA); PG8_STAGE(PG8_SB(0, 1), cB + hstep, voffB); PG8_STAGE(PG8_SA(0, 1), cA + hstep, voffA);
        if (wr == 1) PG8_BAR;
        PG8_WAIT_V(4); PG8_BAR;
        PG8_STAGE(PG8_SB(1, 0), cB + kstep, voffB); PG8_STAGE(PG8_SA(1, 0), cA + kstep, voffA); PG8_STAGE(PG8_SB(1, 1), cB + hstep + kstep, voffB);
        PG8_WAIT_V(6); PG8_BAR;
    }
    for (;;) {
        const bool has_next = S.next(ui + 1, nxt);
        const char* nA = has_next ? (const char*)g.A + (size_t)nxt.pm * tstep : cA; const char* nB = has_next ? (const char*)g.Bt + (size_t)nxt.pn * tstep : cB;
        for (int t = 0; t < nt; t += 2) {
            const bool last = (t == nt - 2);
            const char* a1 = cA + (size_t)(t + 1) * kstep;
            const char* a2 = last ? nA : cA + (size_t)(t + 2) * kstep; const char* b2 = last ? nB : cB + (size_t)(t + 2) * kstep;
            const char* a3 = a2 + kstep; const char* b3 = b2 + kstep;
            if (last && has_next) S.a_ready(nxt);
            if constexpr (SP2) {
            PG8_LDB(B0, 0, 0); PG8_LDB(B1, 0, 1); PG8_SCHED; PG8_LDA(At, 0, 0); PG8_STAGE(PG8_SA(1, 1), a1 + hstep, voffA);
            PG8_WAIT_V(8); PG8_WAIT_L(0); PG8_BAR; PG8_MMA(0, 0, At, B0); PG8_MMA(0, 1, At, B1); PG8_BAR; PG8_SCHED;
            PG8_LDA(At, 0, 1); PG8_STAGE(PG8_SB(0, 0), b2, voffB); PG8_STAGE(PG8_SB(0, 1), b2 + hstep, voffB); PG8_STAGE(PG8_SA(0, 0), a2, voffA);
            PG8_WAIT_V(8); PG8_WAIT_L(0); PG8_BAR; PG8_MMA(1, 0, At, B0); PG8_MMA(1, 1, At, B1); PG8_BAR; PG8_SCHED;
            PG8_LDB(B0, 1, 0); PG8_LDB(B1, 1, 1); PG8_SCHED; PG8_LDA(At, 1, 0); PG8_STAGE(PG8_SA(0, 1), a2 + hstep, voffA);
            PG8_WAIT_V(8); PG8_WAIT_L(0); PG8_BAR; PG8_MMA(0, 0, At, B0); PG8_MMA(0, 1, At, B1); PG8_BAR; PG8_SCHED;
            PG8_LDA(At, 1, 1); PG8_STAGE(PG8_SB(1, 0), b3, voffB); PG8_STAGE(PG8_SB(1, 1), b3 + hstep, voffB); PG8_STAGE(PG8_SA(1, 0), a3, voffA);
            PG8_WAIT_V(8); PG8_WAIT_L(0); PG8_BAR; PG8_MMA(1, 0, At, B0); PG8_MMA(1, 1, At, B1); PG8_BAR; PG8_SCHED;
            } else {
            PG8_LDB(B0, 0, 0); PG8_SCHED; PG8_LDA(At, 0, 0); PG8_STAGE(PG8_SA(1, 1), a1 + hstep, voffA);
            PG8_WAIT_L(8); PG8_BAR; PG8_WAIT_L(0); PG8_MMA(0, 0, At, B0); PG8_BAR; PG8_SCHED;
            PG8_LDB(B1, 0, 1); PG8_STAGE(PG8_SB(0, 0), b2, voffB);
            PG8_BAR; PG8_WAIT_L(0); PG8_MMA(0, 1, At, B1); PG8_BAR;
            PG8_LDA(At, 0, 1); PG8_STAGE(PG8_SA(0, 0), a2, voffA);
            PG8_BAR; PG8_WAIT_L(0); PG8_MMA(1, 0, At, B0); PG8_BAR; PG8_SCHED;
            PG8_STAGE(PG8_SB(0, 1), b2 + hstep, voffB);
            PG8_WAIT_V(6); PG8_BAR; PG8_MMA(1, 1, At, B1); PG8_BAR;
            PG8_LDB(B0, 1, 0); PG8_SCHED; PG8_LDA(At, 1, 0); PG8_STAGE(PG8_SA(0, 1), a2 + hstep, voffA);
            PG8_WAIT_L(8); PG8_BAR; PG8_WAIT_L(0); PG8_MMA(0, 0, At, B0); PG8_BAR; PG8_SCHED;
            PG8_LDB(B1, 1, 1); PG8_STAGE(PG8_SB(1, 0), b3, voffB);
            PG8_BAR; PG8_WAIT_L(0); PG8_MMA(0, 1, At, B1); PG8_BAR;
            PG8_LDA(At, 1, 1); PG8_STAGE(PG8_SA(1, 0), a3, voffA);
            PG8_BAR; PG8_WAIT_L(0); PG8_MMA(1, 0, At, B0); PG8_BAR; PG8_SCHED;
            PG8_STAGE(PG8_SB(1, 1), b3 + hstep, voffB);
            PG8_WAIT_V(6); PG8_BAR; PG8_MMA(1, 1, At, B1); PG8_BAR;
            }
        }
        if constexpr (ALIGN_EPI) { if (wr == 0) PG8_BAR; }
        if constexpr (!Epi::AFTER_DRAIN) { E(acc, cur, wr, wc, fr, fq); S.done(cur); }
        if (!has_next) break;
#pragma unroll
        for (int a = 0; a < 2; ++a)
#pragma unroll
            for (int b = 0; b < 2; ++b)
#pragma unroll
                for (int m = 0; m < 4; ++m)
#pragma unroll
                    for (int n = 0; n < 2; ++n) acc[a][b][m][n] = (f32x4){0.f, 0.f, 0.f, 0.f};
        cur = nxt; cA = nA; cB = nB; ++ui;
        if constexpr (ALIGN_EPI) { if (wr == 1) PG8_BAR; }
    }
    PG8_WAIT_V(0);
    if constexpr (!ALIGN_EPI) { if (wr == 0) PG8_BAR; }
    PG8_BAR;
    if constexpr (Epi::AFTER_DRAIN) { E.fused(acc, cur, wr, wc, fr, fq, lds, wid, lane); S.done(cur); }
#undef PG8_SA
#undef PG8_SB
#undef PG8_STAGE
#undef PG8_LDA
#undef PG8_LDB
#undef PG8_MMA
#undef PG8_WAIT_V
#undef PG8_WAIT_L
#undef PG8_BAR
#undef PG8_SCHED
}
}

namespace cg = cooperative_groups;
typedef unsigned short bf16;
typedef float f32x16 __attribute__((ext_vector_type(16)));
typedef short bf16x8v __attribute__((ext_vector_type(8)));
constexpr int NWV = 8, NTHR = 512;
constexpr int SEQ = 8192, DM = 1024, MTOK = 16384, DFF = 2816, NIN = 1816, NINP = 2048, NMOD = 9216;
constexpr int C_Q = 256, C_KC = 768, C_KS = 1024, C_VS = 1152, C_KW = 1280, C_VW = 1408, C_GATE = 1536, C_S5 = 1560;
constexpr float EPSN = 1e-6f;
constexpr size_t MiB = 1u << 20;
constexpr size_t WS_A = 0;
constexpr size_t WS_XN = 128 * MiB;
constexpr size_t WS_W1T = 160 * MiB;
constexpr size_t WS_W2T = 182 * MiB;
constexpr size_t WS_WINT = 193 * MiB;
constexpr size_t WS_WOUTT = 197 * MiB;
constexpr size_t WS_QN = 200 * MiB;
constexpr size_t WS_KS = 232 * MiB;
constexpr size_t WS_KW = 240 * MiB;
constexpr size_t WS_YS5 = 248 * MiB;
constexpr size_t WS_MOD = 264 * MiB;
constexpr size_t WS_ROPE = 265 * MiB;
constexpr size_t WS_KCMP = 266 * MiB;
constexpr size_t WS_VCMP = 266 * MiB + 512 * 1024;
constexpr size_t WS_S5END = 267 * MiB;
constexpr size_t WS_VTS = 282 * MiB + 68 * 1024;
constexpr size_t WS_VTS_UNUSED_ = 269 * MiB;
constexpr size_t WS_VTW = 287 * MiB + 204 * 1024;
constexpr size_t WS_VTC = 277 * MiB;
constexpr size_t WS_CTL = 278 * MiB;
constexpr size_t CTL_BYTES = 16384;
constexpr size_t WS_WCT = 279 * MiB;
constexpr size_t WS_GLUT = 280 * MiB;
constexpr size_t WS_S5T = 281 * MiB;
constexpr size_t WS_END = 292 * MiB;
constexpr int LDS_BYTES = 147456;

struct KP { const float* in[36]; int ph_lo, ph_hi; };
#define PIN(i) (p.in[(i) + z_])
#define PWS ((unsigned char*)p.in[35 + z_])
#define POUT ((float*)p.in[34 + z_])
#define ZDEF int z_ = 0; asm volatile("" : "+s"(z_))

__device__ __forceinline__ float wsum(float v) {
#define DPPADD_(ctrl, rmask) { const int t_ = __builtin_amdgcn_update_dpp(0, __float_as_int(v), ctrl, rmask, 0xf, false); v += __int_as_float(t_); }
    DPPADD_(0x111, 0xf) DPPADD_(0x112, 0xf) DPPADD_(0x114, 0xf) DPPADD_(0x118, 0xf) DPPADD_(0x142, 0xa) DPPADD_(0x143, 0xc)
#undef DPPADD_
    return __int_as_float(__builtin_amdgcn_readlane(__float_as_int(v), 63));
}
__device__ __forceinline__ float qsum(float v) {
    v += __int_as_float(__builtin_amdgcn_mov_dpp(__float_as_int(v), 0xB1, 0xf, 0xf, true));
    v += __int_as_float(__builtin_amdgcn_mov_dpp(__float_as_int(v), 0x4E, 0xf, 0xf, true));
    return v;
}
__device__ __forceinline__ float wmax(float v) {
#pragma unroll
    for (int o = 32; o > 0; o >>= 1) v = fmaxf(v, __shfl_xor(v, o));
    return v;
}
__device__ __forceinline__ unsigned f2bf(float f) { unsigned u = __builtin_bit_cast(unsigned, f); return (u + 0x7fffu + ((u >> 16) & 1u)) >> 16; }
__device__ __forceinline__ unsigned pk2(float lo, float hi) { return f2bf(lo) | (f2bf(hi) << 16); }
__device__ __forceinline__ float gelu_t(float x) { const float z = 1.5957691216057308f * (x + 0.044715f * x * x * x); return x * __builtin_amdgcn_rcpf(1.0f + __expf(-z)); }
__device__ __forceinline__ float sigm(float x) { return __builtin_amdgcn_rcpf(1.0f + __expf(-x)); }
__device__ __forceinline__ int ltid() { int t = threadIdx.x; asm volatile("" : "+v"(t)); return t; }

__device__ __forceinline__ float wave_max_dpp(float v) {
#define DPPMAX_(ctrl, rmask) { const int t_ = __builtin_amdgcn_update_dpp((int)0xff800000, __float_as_int(v), ctrl, rmask, 0xf, false); v = fmaxf(v, __int_as_float(t_)); }
    DPPMAX_(0x111, 0xf) DPPMAX_(0x112, 0xf) DPPMAX_(0x114, 0xf) DPPMAX_(0x118, 0xf) DPPMAX_(0x142, 0xa) DPPMAX_(0x143, 0xc)
#undef DPPMAX_
    return __int_as_float(__builtin_amdgcn_readlane(__float_as_int(v), 63));
}
#define LDSW() asm volatile("s_waitcnt lgkmcnt(0)" ::: "memory")

__device__ __forceinline__ void ph_mod_rope(const KP& p, float* lds) {
    ZDEF;
    const int tid = ltid(), wave = __builtin_amdgcn_readfirstlane(tid >> 6), lane = tid & 63;
    for (int i = tid; i < 2048; i += NTHR) { const float c = PIN(1)[i]; lds[i] = c / (1.0f + expf(-c)); }
    __syncthreads();
    float* red = lds + 2048;
    float* mod = (float*)(PWS + WS_MOD);
    for (int item = blockIdx.x; item < 144; item += gridDim.x) {
        const int l = item / 72, n0 = (item % 72) * 128;
        const float* W = PIN(2) + (size_t)l * 1024 * NMOD + n0 + 2 * lane;
        float a00 = 0.f, a01 = 0.f, a10 = 0.f, a11 = 0.f;
#pragma unroll 16
        for (int kk = 0; kk < 128; ++kk) { const int k = wave * 128 + kk; const float2 w = *(const float2*)(W + (size_t)k * NMOD); const float s0 = lds[k], s1 = lds[1024 + k];
            a00 += s0 * w.x; a01 += s0 * w.y; a10 += s1 * w.x; a11 += s1 * w.y; }
        red[(wave * 2 + 0) * 128 + 2 * lane] = a00; red[(wave * 2 + 0) * 128 + 2 * lane + 1] = a01;
        red[(wave * 2 + 1) * 128 + 2 * lane] = a10; red[(wave * 2 + 1) * 128 + 2 * lane + 1] = a11;
        __syncthreads();
        if (tid < 256) { const int b = tid >> 7, n = tid & 127; float s = 0.f;
#pragma unroll
            for (int w = 0; w < 8; ++w) s += red[(w * 2 + b) * 128 + n];
            mod[(size_t)(l * 2 + b) * NMOD + n0 + n] = s + PIN(3)[l * NMOD + n0 + n]; }
        __syncthreads();
    }
    const int gid = blockIdx.x * NTHR + tid;
    if (gid < SEQ * 8) { const int s = gid >> 3, i = gid & 7;
        const float inv = expf(-13.122363377404328f * (float)i * 0.125f); const float ang = (float)s * inv;
        float sn, cs; sincosf(ang, &sn, &cs);
        float* rope = (float*)(PWS + WS_ROPE); rope[s * 16 + i] = cs; rope[s * 16 + 8 + i] = sn; }
}

template <int MODE> __device__ __forceinline__ void cvt_item(const float* W, int K, int N, bf16* WT, float* scr, int item, int lane) {
    const int nblk = (N + 31) / 32, kb = item / nblk, nb = item % nblk, k0 = 64 * kb, n0 = 32 * nb;
    const int nn = n0 + (lane & 31);
#pragma unroll 32
    for (int i = 0; i < 32; ++i) { const int kk = 2 * i + (lane >> 5); scr[kk * 33 + (lane & 31)] = (nn < N) ? W[(size_t)(k0 + kk) * N + nn] : 0.f; }
    LDSW();
    const int c = lane & 7;
#pragma unroll
    for (int j = 0; j < 4; ++j) { const int nl = (lane >> 3) + 8 * j, n = n0 + nl; const float* s = scr + (8 * c) * 33 + nl;
        uint4 o; o.x = pk2(s[0 * 33], s[1 * 33]); o.y = pk2(s[2 * 33], s[3 * 33]); o.z = pk2(s[4 * 33], s[5 * 33]); o.w = pk2(s[6 * 33], s[7 * 33]);
        int row = n;
        if (MODE == 1) { const int up = n >= DFF ? 1 : 0, n2 = n - up * DFF; row = 256 * (n2 >> 7) + (n2 & 127) + 128 * up; }
        if (n < N) *(uint4*)(WT + (size_t)row * K + k0 + 8 * c) = o; }
    LDSW();
}

__device__ __forceinline__ void ph_convert(const KP& p, int l, float* lds) {
    ZDEF;
    const int tid = ltid(), wave = __builtin_amdgcn_readfirstlane(tid >> 6), lane = tid & 63;
    const int gw = blockIdx.x * NWV + wave, NGW = gridDim.x * NWV;
    float* scr = lds + wave * (64 * 33 + 16);
    constexpr int I_1 = 16 * 176, I_2 = 44 * 32, I_IN = 16 * 57, I_OUT = 16 * 32, I_Z = 232 * 2;
    constexpr int I_C = 32 * 4;
    constexpr int I_G = 4 * 8;
    constexpr int NITEMS = 2 * I_1 + 2 * I_2 + I_IN + I_OUT + I_Z + 2 * I_C + I_G;
    bf16* W1T = (bf16*)(PWS + WS_W1T); bf16* W2T = (bf16*)(PWS + WS_W2T); bf16* WINT = (bf16*)(PWS + WS_WINT); bf16* WOUTT = (bf16*)(PWS + WS_WOUTT);
    for (int it = gw; it < NITEMS; it += NGW) {
        int r = it;
        if (r < I_1) { cvt_item<1>(PIN(5) + (size_t)l * DM * 2 * DFF, DM, 2 * DFF, W1T, scr, r, lane); continue; } r -= I_1;
        if (r < I_1) { cvt_item<1>(PIN(32) + (size_t)l * DM * 2 * DFF, DM, 2 * DFF, W1T + (size_t)2 * DFF * DM, scr, r, lane); continue; } r -= I_1;
        if (r < I_2) { cvt_item<0>(PIN(6) + (size_t)l * DFF * DM, DFF, DM, W2T, scr, r, lane); continue; } r -= I_2;
        if (r < I_2) { cvt_item<0>(PIN(33) + (size_t)l * DFF * DM, DFF, DM, W2T + (size_t)DM * DFF, scr, r, lane); continue; } r -= I_2;
        if (r < I_IN) { cvt_item<0>(PIN(8) + (size_t)l * DM * NIN, DM, NIN, WINT, scr, r, lane); continue; } r -= I_IN;
        if (r < I_OUT) { cvt_item<0>(PIN(9) + (size_t)l * DM * DM, DM, DM, WOUTT, scr, r, lane); continue; } r -= I_OUT;
        if (r >= I_Z + 2 * I_C) { r -= I_Z + 2 * I_C; cvt_item<0>(PIN(29) + (size_t)l * 65536, 256, 256, (bf16*)(PWS + WS_GLUT), scr, r, lane); continue; }
        if (r >= I_Z) { r -= I_Z; const int kvx = r >= I_C ? 1 : 0; r -= kvx * I_C;
            cvt_item<0>((kvx ? PIN(19) : PIN(17)) + (size_t)l * 2048 * 128, 2048, 128, (bf16*)(PWS + WS_WCT) + (size_t)kvx * 128 * 2048, scr, r, lane); continue; }
        { const int row = NIN + (r >> 1), half = r & 1; *(uint4*)(WINT + (size_t)row * DM + half * 512 + lane * 8) = make_uint4((unsigned)z_, (unsigned)z_, (unsigned)z_, (unsigned)z_); }
    }
}

__device__ __forceinline__ void ph_norm(const float* x, const float* gain, const float* modl, int ish, bf16* XN) {
    const int tid = ltid(), wave = __builtin_amdgcn_readfirstlane(tid >> 6), lane = tid & 63;
    const int gw = blockIdx.x * NWV + wave, NGW = gridDim.x * NWV;
    for (int m = gw; m < MTOK; m += NGW) {
        const int b = m >> 13;
        const float4* xr = (const float4*)(x + (size_t)m * DM) + lane;
        float4 v[4]; float ss = 0.f;
#pragma unroll
        for (int j = 0; j < 4; ++j) { v[j] = xr[64 * j]; ss += (v[j].x * v[j].x + v[j].y * v[j].y) + (v[j].z * v[j].z + v[j].w * v[j].w); }
        const float rinv = rsqrtf(wsum(ss) * (1.0f / DM) + EPSN);
        const float* sh = modl + (size_t)b * NMOD + ish * DM; const float* sc = sh + DM;
#pragma unroll
        for (int j = 0; j < 4; ++j) { const int col = 4 * lane + 256 * j;
            const float4 g4 = *(const float4*)(gain + col), s4 = *(const float4*)(sc + col), h4 = *(const float4*)(sh + col);
            const float o0 = v[j].x * rinv * g4.x * (1.0f + s4.x) + h4.x, o1 = v[j].y * rinv * g4.y * (1.0f + s4.y) + h4.y;
            const float o2 = v[j].z * rinv * g4.z * (1.0f + s4.z) + h4.z, o3 = v[j].w * rinv * g4.w * (1.0f + s4.w) + h4.w;
            uint2 o; o.x = pk2(o0, o1); o.y = pk2(o2, o3); *(uint2*)(XN + (size_t)m * DM + col) = o; }
    }
}

__device__ __forceinline__ void s5_setup(const KP& p, int l, int g, int lane, float& lbr, float& lbi, float (&bre)[16], float (&bim)[16], float& are, float& aim) {
    ZDEF;
    const float lre = PIN(21)[l * 1024 + g * 64 + lane], lim = PIN(22)[l * 1024 + g * 64 + lane], step = expf(PIN(23)[l * 16 + g]);
    are = lre * step; aim = lim * step;
    const float em1 = expm1f(are), e = em1 + 1.0f; float sn, cs; sincosf(aim, &sn, &cs);
    float sh, chh; sincosf(0.5f * aim, &sh, &chh);
    lbr = e * cs; lbi = e * sn;
    const float nr = em1 * cs - 2.0f * sh * sh, ni = lbi;
    const float den = 1.0f / (lre * lre + lim * lim);
    const float cr = (nr * lre + ni * lim) * den, ci = (ni * lre - nr * lim) * den;
    const float4* br4 = (const float4*)(PIN(24) + ((size_t)(l * 16 + g) * 64 + lane) * 16);
    const float4* bi4 = (const float4*)(PIN(25) + ((size_t)(l * 16 + g) * 64 + lane) * 16);
#pragma unroll
    for (int q = 0; q < 4; ++q) { const float4 a = br4[q], c = bi4[q];
        bre[4 * q + 0] = a.x * cr - c.x * ci; bim[4 * q + 0] = a.x * ci + c.x * cr;
        bre[4 * q + 1] = a.y * cr - c.y * ci; bim[4 * q + 1] = a.y * ci + c.y * cr;
        bre[4 * q + 2] = a.z * cr - c.z * ci; bim[4 * q + 2] = a.z * ci + c.z * cr;
        bre[4 * q + 3] = a.w * cr - c.w * ci; bim[4 * q + 3] = a.w * ci + c.w * cr; }
}

__device__ __forceinline__ void ph_s5_table(const KP& p) {
    ZDEF;
    const int tid = ltid();
    const int gid = blockIdx.x * NTHR + tid;
    if (gid < 2048) { const int l = gid >> 10, g = (gid >> 6) & 15, lane = gid & 63;
        float lbr, lbi, bre[16], bim[16], are, aim; s5_setup(p, l, g, lane, lbr, lbi, bre, bim, are, aim);
        float Lr, Li; { const float e = expf(are * 64.0f); float sn, cs; sincosf(aim * 64.0f, &sn, &cs); Lr = e * cs; Li = e * sn; }
        float4* tp = (float4*)((float*)(PWS + WS_S5T) + (size_t)gid * 36);
        tp[0] = make_float4(lbr, lbi, Lr, Li);
#pragma unroll
        for (int q = 0; q < 4; ++q) { tp[1 + q] = make_float4(bre[4 * q], bre[4 * q + 1], bre[4 * q + 2], bre[4 * q + 3]); tp[5 + q] = make_float4(bim[4 * q], bim[4 * q + 1], bim[4 * q + 2], bim[4 * q + 3]); } }
}

__device__ __forceinline__ void s5_load(const float* tbl, int l, int g, int lane, float& lbr, float& lbi, float& Lr, float& Li, float (&bre)[16], float (&bim)[16]) {
    const float4* tp = (const float4*)(tbl + ((size_t)((l * 16 + g) * 64 + lane)) * 36);
    const float4 h = tp[0]; lbr = h.x; lbi = h.y; Lr = h.z; Li = h.w;
#pragma unroll
    for (int q = 0; q < 4; ++q) { const float4 a = tp[1 + q], c = tp[5 + q];
        bre[4 * q] = a.x; bre[4 * q + 1] = a.y; bre[4 * q + 2] = a.z; bre[4 * q + 3] = a.w; bim[4 * q] = c.x; bim[4 * q + 1] = c.y; bim[4 * q + 2] = c.z; bim[4 * q + 3] = c.w; }
}

__device__ __forceinline__ void ph_mixA(const KP& p, int l, float* lds) {
    ZDEF;
    const int tid = ltid(), wave = __builtin_amdgcn_readfirstlane(tid >> 6), lane = tid & 63;
    const int gw = blockIdx.x * NWV + wave, NGW = gridDim.x * NWV;
    const float* U = (const float*)(PWS + WS_A);
    const float* ROPE = (const float*)(PWS + WS_ROPE);
    {
        typedef float f32x4v __attribute__((ext_vector_type(4)));
        typedef short bf16x8c __attribute__((ext_vector_type(8)));
        float* red = lds;
        float* hid = lds + 8 * 2048;
        float* w2s = lds + 8 * 2048 + 2048;
        float* KC = (float*)(PWS + WS_KCMP); bf16* VTC = (bf16*)(PWS + WS_VTC);
        const bf16* W1C = (const bf16*)(PWS + WS_WCT);
        for (int item = blockIdx.x; item < 256; item += gridDim.x) {
            const int rt = item & 31, g = (item >> 5) & 1, kv = (item >> 6) & 1, b = item >> 7, n0 = 16 * rt;
            const int arow = lane & 15, kq = lane >> 4;
            const float* pe = PIN(16) + (size_t)l * 4096 + kv * 2048;
            const bf16* wb = W1C + (size_t)kv * 128 * 2048 + (size_t)arow * 2048 + 8 * kq;
            f32x4v acc[8];
#pragma unroll
            for (int ct = 0; ct < 8; ++ct) acc[ct] = (f32x4v){0.f, 0.f, 0.f, 0.f};
#pragma unroll 2
            for (int ksl = 0; ksl < 8; ++ksl) {
                const int k0 = 256 * wave + 32 * ksl + 8 * kq, jt = k0 >> 6, d = k0 & 63;
                const int tok = min(16 * (n0 + arow) + jt, SEQ - 1);
                const float4* up = (const float4*)(U + (size_t)(b * SEQ + tok) * NINP + C_KC + kv * 128 + g * 64 + d);
                const float4* pp = (const float4*)(pe + jt * 64 + d);
                const float4 u0 = up[0], u1 = up[1], p0 = pp[0], p1 = pp[1];
                union { unsigned u[4]; bf16x8c v; } af;
                af.u[0] = pk2(u0.x + p0.x, u0.y + p0.y); af.u[1] = pk2(u0.z + p0.z, u0.w + p0.w); af.u[2] = pk2(u1.x + p1.x, u1.y + p1.y); af.u[3] = pk2(u1.z + p1.z, u1.w + p1.w);
#pragma unroll
                for (int ct = 0; ct < 8; ++ct) { const bf16x8c bfr = *(const bf16x8c*)(wb + (size_t)ct * 16 * 2048 + 256 * wave + 32 * ksl);
                    acc[ct] = __builtin_amdgcn_mfma_f32_16x16x32_bf16(af.v, bfr, acc[ct], 0, 0, 0); }
            }
            __syncthreads();
            { const float4* w2g = (const float4*)((kv ? PIN(20) : PIN(18)) + (size_t)l * 128 * 64);
#pragma unroll
              for (int q = 0; q < 4; ++q) ((float4*)w2s)[tid + 512 * q] = w2g[tid + 512 * q]; }
#pragma unroll
            for (int ct = 0; ct < 8; ++ct)
#pragma unroll
                for (int i = 0; i < 4; ++i) red[(wave * 16 + 4 * kq + i) * 128 + 16 * ct + arow] = acc[ct][i];
            __syncthreads();
#pragma unroll
            for (int q = 0; q < 4; ++q) { const int o = tid + 512 * q; float s = 0.f;
#pragma unroll
                for (int w = 0; w < 8; ++w) s += red[w * 2048 + o];
                hid[o] = gelu_t(s); }
            __syncthreads();
            {
                const int d = lane;
                const float* w2 = w2s + d;
                float o0 = 0.f, o1 = 0.f;
                const float* h0 = hid + (2 * wave) * 128; const float* h1 = h0 + 128;
#pragma unroll 8
                for (int jj = 0; jj < 128; ++jj) { const float w = w2[jj * 64]; o0 += h0[jj] * w; o1 += h1[jj] * w; }
#pragma unroll
                for (int q = 0; q < 2; ++q) { const int n = n0 + 2 * wave + q; float o = q ? o1 : o0;
                    if (kv == 0) {
                        const float y = o * rsqrtf(wsum(o * o) * (1.0f / 64.0f) + EPSN) * PIN(15)[l * 192 + d];
                        const float pr = __shfl_xor(y, 8); const int pos = min(16 * n + 31, SEQ - 1);
                        const float cs = ROPE[pos * 16 + (d & 7)], sn = ROPE[pos * 16 + 8 + (d & 7)];
                        o = d < 8 ? y * cs - pr * sn : (d < 16 ? y * cs + pr * sn : y);
                    }
                    if (n >= 511) o = 0.f;
                    if (kv == 0) { const size_t ki = (size_t)(b * 2 + g) * 32768 + (size_t)(n >> 5) * 2048 + ((((d & 31) >> 3) * 64) + (n & 31) + 32 * (d >> 5)) * 8 + (d & 7);
                        const unsigned hb = f2bf(o); const float lo = o - __uint_as_float(hb << 16);
                        ((bf16*)KC)[ki] = (bf16)hb; ((bf16*)KC)[4 * 32768 + ki] = (bf16)f2bf(lo); }
                    else { const int kk = n & 31, rem = kk & 15, hh2 = (rem >> 2) & 1, e = 4 * (rem >> 3) + (rem & 3);
                        VTC[(size_t)(b * 2 + g) * 32768 + (size_t)(n >> 5) * 2048 + (((d >> 5) * 2 + (kk >> 4)) * 64 + (d & 31) + 32 * hh2) * 8 + e] = (bf16)f2bf(o); } }
            }
        }
        __syncthreads();
    }
    {
        float* ut = lds;
        float* pl = lds + 47 * 256;
        bf16* YMIX = (bf16*)(PWS + WS_XN);
        const int pr_ = lane & 31, ph_ = lane >> 5, pgi = wave >> 1, pdd = pgi * 64 + 32 * (wave & 1) + pr_;
        bf16x8v pwf[4];
#pragma unroll
        for (int ks = 0; ks < 4; ++ks) { const float* wp = PIN(11) + (size_t)l * 16384 + pgi * 4096 + (size_t)(16 * ks + 8 * ph_) * 64 + (pdd & 63);
            union { unsigned u[4]; bf16x8v v; } bf_;
#pragma unroll
            for (int q = 0; q < 4; ++q) bf_.u[q] = pk2(wp[(2 * q) * 64], wp[(2 * q + 1) * 64]);
            pwf[ks] = bf_.v; }
        const float pbv = PIN(12)[l * 256 + pdd], psc = PIN(13)[l * 256 + pdd];
        for (int item = blockIdx.x; item < 512; item += gridDim.x) {
            const int row0 = item * 32, b = row0 >> 13, t0 = row0 & (SEQ - 1);
            for (int i = tid; i < 47 * 64; i += NTHR) { const int r = i >> 6, c4 = i & 63, t = t0 - 15 + r;
                float4 v = make_float4(0.f, 0.f, 0.f, 0.f); if (t >= 0) v = *(const float4*)(U + (size_t)(b * SEQ + t) * NINP + 4 * c4);
                ((float4*)ut)[i] = v; }
            __syncthreads();
            for (int i = tid; i < 32 * 256; i += NTHR) { const int tt = i >> 8, ch = i & 255, gi = ch >> 6, w = 2 << gi, t = t0 + tt; const int cnt = min(t + 1, w);
                float s = 0.f; for (int q = 0; q < cnt; ++q) s += ut[(tt + 15 - q) * 256 + ch];
                pl[i] = s * __builtin_amdgcn_rcpf((float)cnt) - ut[(tt + 15) * 256 + ch]; }
            __syncthreads();
            {
                f32x16 acc;
#pragma unroll
                for (int i = 0; i < 16; ++i) acc[i] = 0.f;
#pragma unroll
                for (int ks = 0; ks < 4; ++ks) { const float* ap = pl + pr_ * 256 + pgi * 64 + 16 * ks + 8 * ph_;
                    const float4 f0 = *(const float4*)ap, f1 = *(const float4*)(ap + 4);
                    union { unsigned u[4]; bf16x8v v; } af; af.u[0] = pk2(f0.x, f0.y); af.u[1] = pk2(f0.z, f0.w); af.u[2] = pk2(f1.x, f1.y); af.u[3] = pk2(f1.z, f1.w);
                    acc = __builtin_amdgcn_mfma_f32_32x32x16_bf16(af.v, pwf[ks], acc, 0, 0, 0); }
                __syncthreads();
#pragma unroll
                for (int i = 0; i < 16; ++i) { const int rr = 8 * (i >> 2) + 4 * ph_ + (i & 3); ut[rr * 256 + pdd] = (acc[i] + pbv) * psc; }
            }
            __syncthreads();
#pragma unroll
            for (int q = 0; q < 4; ++q) { const int tt = 4 * wave + q; float v[4]; float ss = 0.f;
#pragma unroll
                for (int jx = 0; jx < 4; ++jx) { v[jx] = ut[tt * 256 + lane + 64 * jx]; ss += v[jx] * v[jx]; }
                const float rinv = rsqrtf(wsum(ss) * (1.0f / 256.0f) + EPSN);
#pragma unroll
                for (int jx = 0; jx < 4; ++jx) YMIX[(size_t)(row0 + tt) * DM + lane + 64 * jx] = (bf16)f2bf(v[jx] * rinv * PIN(10)[l * DM + lane + 64 * jx]); }
            __syncthreads();
        }
    }
    {
        bf16* VTS = (bf16*)(PWS + WS_VTS); bf16* VTW = (bf16*)(PWS + WS_VTW);
        const int rowid = tid >> 1, hh = tid & 1, kind = rowid >> 7, g = (rowid >> 6) & 1, d = rowid & 63;
        for (int item = blockIdx.x; item < 512; item += gridDim.x) {
            const int row0 = item * 32, b = row0 >> 13, k0 = row0 & (SEQ - 1);
            const float* up = U + (size_t)row0 * NINP + (kind ? C_VW : C_VS) + g * 64 + d;
            unsigned w[8];
#pragma unroll
            for (int s2 = 0; s2 < 2; ++s2)
#pragma unroll
                for (int jp = 0; jp < 4; ++jp) { const int j = 2 * jp; const int ka = 16 * s2 + 8 * (j >> 2) + 4 * hh + (j & 3);
                    w[s2 * 4 + jp] = pk2(up[(size_t)ka * NINP], up[(size_t)(ka + 1) * NINP]); }
            bf16* dst = (kind ? VTW : VTS) + (size_t)(b * 2 + g) * SEQ * 64 + (size_t)(k0 >> 5) * 2048 + (((d >> 5) * 2) * 64 + (d & 31) + 32 * hh) * 8;
            *(uint4*)dst = make_uint4(w[0], w[1], w[2], w[3]); *(uint4*)(dst + 512) = make_uint4(w[4], w[5], w[6], w[7]);
        }
    }
    {
        float* QN = (float*)(PWS + WS_QN); bf16* KS = (bf16*)(PWS + WS_KS); bf16* KW = (bf16*)(PWS + WS_KW);
        const float qg = PIN(14)[l * 64 + lane], ksg = PIN(15)[l * 192 + 64 + lane], kwg = PIN(15)[l * 192 + 128 + lane];
        for (int m0 = gw; m0 < MTOK; m0 += 2 * NGW) {
            float vv[2][12]; float csn[2][2];
#pragma unroll
            for (int e = 0; e < 2; ++e) { const int m = min(m0 + e * NGW, MTOK - 1), t = m & (SEQ - 1); const float* u = U + (size_t)m * NINP;
                csn[e][0] = ROPE[t * 16 + (lane & 7)]; csn[e][1] = ROPE[t * 16 + 8 + (lane & 7)];
#pragma unroll
                for (int h = 0; h < 12; ++h) vv[e][h] = u[h < 8 ? C_Q + h * 64 + lane : (h < 10 ? C_KS + (h - 8) * 64 + lane : C_KW + (h - 10) * 64 + lane)]; }
#pragma unroll
            for (int e = 0; e < 2; ++e) { const int m = m0 + e * NGW, t = m & (SEQ - 1); const float cs = csn[e][0], sn = csn[e][1];
                if (m >= MTOK) continue;
#pragma unroll
                for (int h = 0; h < 12; ++h) {
                    const float v = vv[e][h];
                    const float gn = h < 8 ? qg : (h < 10 ? ksg : kwg);
                    const float y = v * rsqrtf(wsum(v * v) * (1.0f / 64.0f) + EPSN) * gn;
                    const float pr = __int_as_float(__builtin_amdgcn_mov_dpp(__float_as_int(y), 0x128, 0xf, 0xf, true));
                    const float o = lane < 8 ? y * cs - pr * sn : (lane < 16 ? y * cs + pr * sn : y);
                    if (h < 8) QN[(size_t)m * 512 + h * 64 + lane] = o * 0.18033688011112042f;
                    else { const int gg = h & 1, bgi = (m >> 13) * 2 + gg;
                        const size_t di = (size_t)bgi * SEQ * 64 + (size_t)(t >> 5) * 2048 + ((((lane & 31) >> 3) * 64) + (t & 31) + 32 * (lane >> 5)) * 8 + (lane & 7);
                        (h < 10 ? KS : KW)[di] = (bf16)f2bf(o); }
                }
            }
        }
    }
    {
        float* SE = (float*)(PWS + WS_S5END);
        for (int it = gw; it < 4096; it += NGW) {
            const int c = it & 127, g = (it >> 7) & 15, b = it >> 11;
            float lbr, lbi, bre[16], bim[16], Lr_, Li_; s5_load((const float*)(PWS + WS_S5T), l, g, lane, lbr, lbi, Lr_, Li_, bre, bim);
            float xr = 0.f, xi = 0.f;
            const float* up = U + (size_t)(b * SEQ + c * 64) * NINP + C_S5 + g * 16;
            float* us = lds + wave * 1024;
            { const float4* ul = (const float4*)(up + (size_t)lane * NINP); const float4 a0 = ul[0], a1 = ul[1], a2 = ul[2], a3 = ul[3];
              float4* ud = (float4*)(us + lane * 16); ud[0] = a0; ud[1] = a1; ud[2] = a2; ud[3] = a3; }
            LDSW();
            for (int s = 0; s < 64; ++s) {
                const float4* u4 = (const float4*)(us + s * 16);
                float bur = 0.f, bui = 0.f;
#pragma unroll
                for (int q = 0; q < 4; ++q) { const float4 uv = u4[q];
                    bur += bre[4 * q] * uv.x + bre[4 * q + 1] * uv.y + bre[4 * q + 2] * uv.z + bre[4 * q + 3] * uv.w;
                    bui += bim[4 * q] * uv.x + bim[4 * q + 1] * uv.y + bim[4 * q + 2] * uv.z + bim[4 * q + 3] * uv.w; }
                const float nxr = lbr * xr - lbi * xi + bur, nxi = lbr * xi + lbi * xr + bui; xr = nxr; xi = nxi;
            }
            LDSW();
            *(float2*)(SE + ((size_t)((b * 16 + g) * 128 + c) * 64 + lane) * 2) = make_float2(xr, xi);
        }
    }
}

__device__ __forceinline__ unsigned cvtpk(float lo, float hi) { unsigned r; asm volatile("v_cvt_pk_bf16_f32 %0, %1, %2" : "=v"(r) : "v"(lo), "v"(hi)); return r; }
template <bool MASK> __device__ __forceinline__ void sm_update(f32x16& acc, int d1, int d2, float& m, float& ls, f32x16& o0, f32x16& o1, bf16x8v (&pb)[2]) {
    float tmax = -1e30f;
#pragma unroll
    for (int i = 0; i < 16; ++i) { if (MASK) { const int cst = (i & 3) + 8 * (i >> 2); acc[i] = (cst <= d1 && cst > d2) ? acc[i] : -1e30f; } tmax = fmaxf(tmax, acc[i]); }
    tmax = fmaxf(tmax, __shfl_xor(tmax, 32));
    const float mn = fmaxf(m, tmax), alpha = __builtin_amdgcn_exp2f(m - mn);
    float ps = 0.f;
#pragma unroll
    for (int i = 0; i < 16; ++i) { float pv = __builtin_amdgcn_exp2f(acc[i] - mn); if (MASK) pv = acc[i] > -1e29f ? pv : 0.f; acc[i] = pv; ps += pv; }
    ls = ls * alpha + ps; m = mn;
    o0 *= alpha; o1 *= alpha;
#pragma unroll
    for (int s = 0; s < 2; ++s) { union { unsigned u[4]; bf16x8v v; } pk;
#pragma unroll
        for (int q = 0; q < 4; ++q) pk.u[q] = cvtpk(acc[8 * s + 2 * q], acc[8 * s + 2 * q + 1]);
        pb[s] = pk.v; }
}
__device__ __forceinline__ void sm_update_fast(f32x16& acc, bool sel, float& m, float& ls, f32x16& o0, f32x16& o1, bf16x8v (&pb)[2]) {
    float tmax = acc[0];
#pragma unroll
    for (int i = 1; i < 16; ++i) tmax = fmaxf(tmax, acc[i]);
    tmax = sel ? tmax : -1e30f;
    if (__any(tmax > m + 8.0f)) {
        const float t2 = fmaxf(tmax, __shfl_xor(tmax, 32)), mn = fmaxf(m, t2), alpha = __builtin_amdgcn_exp2f(m - mn);
        ls *= alpha; o0 *= alpha; o1 *= alpha; m = mn;
    }
    float ps = 0.f;
#pragma unroll
    for (int i = 0; i < 16; ++i) { const float pv = __builtin_amdgcn_exp2f(acc[i] - m); acc[i] = pv; ps += pv; }
    ls += sel ? ps : 0.f;
#pragma unroll
    for (int s = 0; s < 2; ++s) { union { unsigned u[4]; bf16x8v v; } pk;
#pragma unroll
        for (int q = 0; q < 4; ++q) { const unsigned w = cvtpk(acc[8 * s + 2 * q], acc[8 * s + 2 * q + 1]); pk.u[q] = sel ? w : 0u; }
        pb[s] = pk.v; }
}

__device__ __forceinline__ void nsa_load(const bf16* kbase, const bf16* vbase, int key0, bf16x8v (&kb)[4], bf16x8v (&va)[4], bool noload) {
#ifdef PROBE_NOLOAD
    if (noload) { const short sv = (short)key0;
#pragma unroll
        for (int ks = 0; ks < 4; ++ks) { kb[ks] = (bf16x8v){sv, sv, sv, sv, sv, sv, sv, sv}; va[ks] = kb[ks]; }
        return; }
#endif
    const bf16* kp = kbase + (size_t)(key0 >> 5) * 2048; const bf16* vp = vbase + (size_t)(key0 >> 5) * 2048;
#pragma unroll
    for (int ks = 0; ks < 4; ++ks) { kb[ks] = *(const bf16x8v*)(kp + 512 * ks); va[ks] = *(const bf16x8v*)(vp + 512 * ks); }
}
__device__ __forceinline__ void nsa_compute(const bf16x8v (&kb)[4], const bf16x8v (&va)[4], const bf16x8v (&qb)[4], bool full, bool sel, int d1, int d2, float& m, float& ls, f32x16& o0, f32x16& o1) {
    f32x16 acc;
#pragma unroll
    for (int i = 0; i < 16; ++i) acc[i] = 0.f;
#pragma unroll
    for (int ks = 0; ks < 4; ++ks) acc = __builtin_amdgcn_mfma_f32_32x32x16_bf16(kb[ks], qb[ks], acc, 0, 0, 0);
    bf16x8v pb[2];
    if (full) sm_update_fast(acc, sel, m, ls, o0, o1, pb);
    else sm_update<true>(acc, d1, d2, m, ls, o0, o1, pb);
    o0 = __builtin_amdgcn_mfma_f32_32x32x16_bf16(va[0], pb[0], o0, 0, 0, 0); o0 = __builtin_amdgcn_mfma_f32_32x32x16_bf16(va[1], pb[1], o0, 0, 0, 0);
    o1 = __builtin_amdgcn_mfma_f32_32x32x16_bf16(va[2], pb[0], o1, 0, 0, 0); o1 = __builtin_amdgcn_mfma_f32_32x32x16_bf16(va[3], pb[1], o1, 0, 0, 0);
}

template <bool FIRST> __device__ __forceinline__ void nsa_out(float* op, const f32x16& o0, const f32x16& o1, float sc, bool dry) {
    if (dry) return;
#pragma unroll
    for (int a = 0; a < 4; ++a) {
        float4 v0 = make_float4(o0[4 * a] * sc, o0[4 * a + 1] * sc, o0[4 * a + 2] * sc, o0[4 * a + 3] * sc), v1 = make_float4(o1[4 * a] * sc, o1[4 * a + 1] * sc, o1[4 * a + 2] * sc, o1[4 * a + 3] * sc);
        if (!FIRST) { const float4 p0 = *(const float4*)(op + 8 * a), p1 = *(const float4*)(op + 32 + 8 * a); v0.x += p0.x; v0.y += p0.y; v0.z += p0.z; v0.w += p0.w; v1.x += p1.x; v1.y += p1.y; v1.z += p1.z; v1.w += p1.w; }
        *(float4*)(op + 8 * a) = v0; *(float4*)(op + 32 + 8 * a) = v1; }
}
__device__ __forceinline__ void ph_mixB(const KP& p, int l, float* lds, bool dry, int parts) {
    ZDEF;
    const int tid = ltid(), wave = __builtin_amdgcn_readfirstlane(tid >> 6), lane = tid & 63;
    const int vb = (gridDim.x % 8 == 0) ? (int)(blockIdx.x % 8) * (int)(gridDim.x / 8) + (int)(blockIdx.x / 8) : (int)blockIdx.x;
    const int gw = vb * NWV + wave, NGW = gridDim.x * NWV;
    const float* U = (const float*)(PWS + WS_A);
    float* QN = (float*)(PWS + WS_QN); const bf16* KSb = (const bf16*)(PWS + WS_KS); const bf16* KWb = (const bf16*)(PWS + WS_KW);
    const float* KC = (const float*)(PWS + WS_KCMP);
    const bf16* VTS = (const bf16*)(PWS + WS_VTS); const bf16* VTW = (const bf16*)(PWS + WS_VTW); const bf16* VTC = (const bf16*)(PWS + WS_VTC);
    float* wl = lds + wave * 2112;
    float* Gs = wl; float* Es = wl + 1024; unsigned long long* selm = (unsigned long long*)(wl + 2048);
#ifndef NO_NSA
    if (parts & 1)
    for (int uu = gw; uu < 2048; uu += NGW)
    for (int ui = 0; ui < 2; ++ui) {
        const int bg = uu >> 9, ti = ui == 0 ? (uu & 511) : 1023 - (uu & 511);
        const int b = bg >> 1, g = bg & 1, t0 = ti * 8;
        const int c = lane & 31, h = lane >> 5, ql = c >> 2, r = c & 3;
        const int t = t0 + ql;
        const size_t row = (size_t)b * SEQ + t;
        float qf[32];
        { const float4* qp = (const float4*)(QN + row * 512 + (g * 4 + r) * 64 + 32 * h);
#pragma unroll
          for (int i = 0; i < 8; ++i) { const float4 v = qp[i]; qf[4 * i] = v.x; qf[4 * i + 1] = v.y; qf[4 * i + 2] = v.z; qf[4 * i + 3] = v.w; } }
#pragma unroll
        for (int i = 0; i < 16; ++i) { Gs[64 * i + lane] = 0.f; Es[64 * i + lane] = 0.f; }
        const int nv = (t >= 31) ? ((t - 31) >> 4) + 1 : 0;
        const int nvmax = (t0 + 7 >= 31) ? ((t0 + 7 - 31) >> 4) + 1 : 0, ntile = (nvmax + 31) >> 5;
        const bf16* kcb = (const bf16*)KC + (size_t)bg * 32768 + lane * 8;
        bf16x8v qb[4], qbl[4];
#pragma unroll
        for (int ks = 0; ks < 4; ++ks) { union { unsigned u[4]; bf16x8v v; } ph_, pl_;
#pragma unroll
            for (int q = 0; q < 4; ++q) { const float a0 = qf[8 * ks + 2 * q], a1 = qf[8 * ks + 2 * q + 1]; const unsigned h0 = f2bf(a0), h1 = f2bf(a1);
                ph_.u[q] = h0 | (h1 << 16); pl_.u[q] = pk2(a0 - __uint_as_float(h0 << 16), a1 - __uint_as_float(h1 << 16)); }
            qb[ks] = ph_.v; qbl[ks] = pl_.v; }
        float mc = -1e30f, lc = 0.f;
        bf16x8v kfa[8];
#pragma unroll
        for (int i = 0; i < 4; ++i) { kfa[i] = *(const bf16x8v*)(kcb + 512 * i); kfa[4 + i] = *(const bf16x8v*)(kcb + 4 * 32768 + 512 * i); }
        for (int kt = 0; kt < ntile; ++kt) {
            f32x16 acc;
#pragma unroll
            for (int i = 0; i < 16; ++i) acc[i] = 0.f;
            const bf16* kpn = kcb + (size_t)min(kt + 1, ntile - 1) * 2048;
            bf16x8v kfb[8];
#pragma unroll
            for (int i = 0; i < 4; ++i) { kfb[i] = *(const bf16x8v*)(kpn + 512 * i); kfb[4 + i] = *(const bf16x8v*)(kpn + 4 * 32768 + 512 * i); }
#pragma unroll
            for (int ks = 0; ks < 4; ++ks) { acc = __builtin_amdgcn_mfma_f32_32x32x16_bf16(kfa[ks], qbl[ks], acc, 0, 0, 0); acc = __builtin_amdgcn_mfma_f32_32x32x16_bf16(kfa[4 + ks], qb[ks], acc, 0, 0, 0); }
#pragma unroll
            for (int ks = 0; ks < 4; ++ks) acc = __builtin_amdgcn_mfma_f32_32x32x16_bf16(kfa[ks], qb[ks], acc, 0, 0, 0);
#pragma unroll
            for (int i = 0; i < 8; ++i) kfa[i] = kfb[i];
            const int d1 = nv - 1 - (32 * kt + 4 * h);
            float tmax = -1e30f;
#pragma unroll
            for (int i = 0; i < 16; ++i) { const int cst = (i & 3) + 8 * (i >> 2); acc[i] = cst <= d1 ? acc[i] : -1e30f; tmax = fmaxf(tmax, acc[i]); }
            tmax = fmaxf(tmax, __shfl_xor(tmax, 32));
            const float mn = fmaxf(mc, tmax); float ps = 0.f;
#pragma unroll
            for (int i = 0; i < 16; ++i) ps += acc[i] > -1e29f ? __builtin_amdgcn_exp2f(acc[i] - mn) : 0.f;
            ps += __shfl_xor(ps, 32);
            lc = lc * __builtin_amdgcn_exp2f(mc - mn) + ps; mc = mn;
        }
        const float invc = lc > 0.f ? 1.0f / lc : 0.f;
        const float* gt = U + row * NINP + C_GATE + (g * 4 + r) * 3;
        float* outp = QN + row * 512 + (g * 4 + r) * 64 + 4 * h;
        {
            f32x16 oc0, oc1;
#pragma unroll
            for (int i = 0; i < 16; ++i) { oc0[i] = 0.f; oc1[i] = 0.f; }
            const bf16* vcb = VTC + (size_t)bg * 32768 + lane * 8;
#pragma unroll
            for (int i = 0; i < 4; ++i) { kfa[i] = *(const bf16x8v*)(kcb + 512 * i); kfa[4 + i] = *(const bf16x8v*)(kcb + 4 * 32768 + 512 * i); }
            for (int kt = 0; kt < ntile; ++kt) {
                f32x16 acc;
#pragma unroll
                for (int i = 0; i < 16; ++i) acc[i] = 0.f;
                const bf16* kpn = kcb + (size_t)min(kt + 1, ntile - 1) * 2048;
                bf16x8v kfb[8];
#pragma unroll
                for (int i = 0; i < 4; ++i) { kfb[i] = *(const bf16x8v*)(kpn + 512 * i); kfb[4 + i] = *(const bf16x8v*)(kpn + 4 * 32768 + 512 * i); }
                const bf16x8v va00 = *(const bf16x8v*)(vcb + 2048 * kt), va01 = *(const bf16x8v*)(vcb + 2048 * kt + 512);
                const bf16x8v va10 = *(const bf16x8v*)(vcb + 2048 * kt + 1024), va11 = *(const bf16x8v*)(vcb + 2048 * kt + 1536);
#pragma unroll
                for (int ks = 0; ks < 4; ++ks) { acc = __builtin_amdgcn_mfma_f32_32x32x16_bf16(kfa[ks], qbl[ks], acc, 0, 0, 0); acc = __builtin_amdgcn_mfma_f32_32x32x16_bf16(kfa[4 + ks], qb[ks], acc, 0, 0, 0); }
#pragma unroll
                for (int ks = 0; ks < 4; ++ks) acc = __builtin_amdgcn_mfma_f32_32x32x16_bf16(kfa[ks], qb[ks], acc, 0, 0, 0);
#pragma unroll
                for (int i = 0; i < 8; ++i) kfa[i] = kfb[i];
                const int d1 = nv - 1 - (32 * kt + 4 * h);
#pragma unroll
                for (int i = 0; i < 16; ++i) { const int cst = (i & 3) + 8 * (i >> 2); acc[i] = cst <= d1 ? __builtin_amdgcn_exp2f(acc[i] - mc) * invc : 0.f; }
#pragma unroll
                for (int a = 0; a < 4; ++a) { float G = (acc[4 * a] + acc[4 * a + 1]) + (acc[4 * a + 2] + acc[4 * a + 3]), E = acc[4 * a + 3];
                    G = qsum(G); E = qsum(E);
                    if (r == 0) { const int j = 8 * kt + 2 * a + h; Gs[ql * 128 + j] = G; Es[ql * 128 + j] = E; } }
                bf16x8v pb[2];
#pragma unroll
                for (int s = 0; s < 2; ++s) { union { unsigned u[4]; bf16x8v v; } pk;
#pragma unroll
                    for (int q = 0; q < 4; ++q) pk.u[q] = cvtpk(acc[8 * s + 2 * q], acc[8 * s + 2 * q + 1]);
                    pb[s] = pk.v; }
                oc0 = __builtin_amdgcn_mfma_f32_32x32x16_bf16(va00, pb[0], oc0, 0, 0, 0); oc0 = __builtin_amdgcn_mfma_f32_32x32x16_bf16(va01, pb[1], oc0, 0, 0, 0);
                oc1 = __builtin_amdgcn_mfma_f32_32x32x16_bf16(va10, pb[0], oc1, 0, 0, 0); oc1 = __builtin_amdgcn_mfma_f32_32x32x16_bf16(va11, pb[1], oc1, 0, 0, 0);
            }
            nsa_out<true>(outp, oc0, oc1, sigm(gt[0]), dry);
        }
        LDSW();
        for (int q2 = 0; q2 < 8; ++q2) {
            const int cur = (t0 + q2) >> 6;
            unsigned long long mlo = 0ull, mhi = 0ull;
            if (cur < 16) { mlo = (2ull << cur) - 1ull; }
            else {
                const float* Gq = Gs + q2 * 128; const float* Eq = Es + q2 * 128;
                float v0, v1;
                { const int j = lane; const float im = Gq[j] - 0.5f * Eq[j] + (j > 0 ? 0.5f * Eq[j - 1] : 0.f);
                  const bool forced = (j == 0) || (j == cur) || (j == cur - 1); v0 = (j <= cur) ? (forced ? -INFINITY : im) : -1e30f; }
                { const int j = lane + 64; const float im = Gq[j] - 0.5f * Eq[j] + 0.5f * Eq[j - 1];
                  const bool forced = (j == cur) || (j == cur - 1); v1 = (j <= cur) ? (forced ? -INFINITY : im) : -1e30f; }
                mlo = 1ull;
                if (cur < 64) mlo |= 1ull << cur; else mhi |= 1ull << (cur - 64);
                if (cur - 1 < 64) mlo |= 1ull << (cur - 1); else mhi |= 1ull << (cur - 1 - 64);
                for (int i = 0; i < 13; ++i) {
                    const float mxv = wave_max_dpp(fmaxf(v0, v1));
                    const unsigned long long b0 = __ballot(v0 == mxv);
                    if (b0 != 0ull) { const int ln = __ffsll((long long)b0) - 1; mlo |= 1ull << ln; if (lane == ln) v0 = -INFINITY; }
                    else { const unsigned long long b1 = __ballot(v1 == mxv); const int ln = __ffsll((long long)b1) - 1; mhi |= 1ull << ln; if (lane == ln) v1 = -INFINITY; }
                }
            }
            if (lane == 0) { selm[2 * q2] = mlo; selm[2 * q2 + 1] = mhi; }
        }
        LDSW();
        const unsigned long long mylo = selm[2 * ql], myhi = selm[2 * ql + 1];
        const int jmax = (t0 + 7) >> 6;
        {
            f32x16 o0, o1;
#pragma unroll
            for (int i = 0; i < 16; ++i) { o0[i] = 0.f; o1[i] = 0.f; }
            float m = -1e30f, ls = 0.f;
            const bf16* kbase = KSb + (size_t)bg * SEQ * 64 + lane * 8;
            const bf16* vbase = VTS + (size_t)bg * SEQ * 64 + lane * 8;
            const int smax = (t0 + 7) >> 5;
            bf16x8v kbA[4], vaA[4], kbB[4], vaB[4];
            nsa_load(kbase, vbase, 0, kbA, vaA, dry);
            for (int sj = 0; sj <= smax; sj += 2) {
                nsa_load(kbase, vbase, 32 * min(sj + 1, smax), kbB, vaB, dry);
                {
                    const int j = sj >> 1, key0 = 32 * sj;
                    const bool sel = (((j < 64 ? mylo : myhi) >> (j & 63)) & 1ull) != 0ull;
                    const unsigned long long sb = __ballot(sel);
                    if (sb != 0ull) nsa_compute(kbA, vaA, qb, key0 + 31 <= t0, sel, (sel ? t : -1) - (key0 + 4 * h), -1000000, m, ls, o0, o1);
                }
                nsa_load(kbase, vbase, 32 * min(sj + 2, smax), kbA, vaA, dry);
                if (sj + 1 <= smax) {
                    const int j = sj >> 1, key0 = 32 * (sj + 1);
                    const bool sel = (((j < 64 ? mylo : myhi) >> (j & 63)) & 1ull) != 0ull;
                    const unsigned long long sb = __ballot(sel);
                    if (sb != 0ull) nsa_compute(kbB, vaB, qb, key0 + 31 <= t0, sel, (sel ? t : -1) - (key0 + 4 * h), -1000000, m, ls, o0, o1);
                }
            }
            ls += __shfl_xor(ls, 32);
            nsa_out<false>(outp, o0, o1, sigm(gt[1]) / ls, dry);
        }
        {
            f32x16 o0, o1;
#pragma unroll
            for (int i = 0; i < 16; ++i) { o0[i] = 0.f; o1[i] = 0.f; }
            float m = -1e30f, ls = 0.f;
            const bf16* kbase = KWb + (size_t)bg * SEQ * 64 + lane * 8;
            const bf16* vbase = VTW + (size_t)bg * SEQ * 64 + lane * 8;
            const int s0 = max(t0 - 511, 0) >> 5, s1 = (t0 + 7) >> 5;
            bf16x8v kbA[4], vaA[4], kbB[4], vaB[4];
            nsa_load(kbase, vbase, 32 * s0, kbA, vaA, dry);
            for (int sj = s0; sj <= s1; sj += 2) {
                nsa_load(kbase, vbase, 32 * min(sj + 1, s1), kbB, vaB, dry);
                { const int key0 = 32 * sj;
                  nsa_compute(kbA, vaA, qb, (key0 + 31 <= t0) && (key0 > t0 + 7 - 512), true, t - (key0 + 4 * h), t - 512 - (key0 + 4 * h), m, ls, o0, o1); }
                nsa_load(kbase, vbase, 32 * min(sj + 2, s1), kbA, vaA, dry);
                if (sj + 1 <= s1) { const int key0 = 32 * (sj + 1);
                  nsa_compute(kbB, vaB, qb, (key0 + 31 <= t0) && (key0 > t0 + 7 - 512), true, t - (key0 + 4 * h), t - 512 - (key0 + 4 * h), m, ls, o0, o1); }
            }
            ls += __shfl_xor(ls, 32);
            nsa_out<false>(outp, o0, o1, sigm(gt[2]) / ls, dry);
        }
    }
#endif
#ifndef NO_S5B
    if (parts & 2) {
        typedef float f32x4v __attribute__((ext_vector_type(4)));
        const float* SE = (const float*)(PWS + WS_S5END); float* YS5 = (float*)(PWS + WS_YS5);
        float* us = wl;
        unsigned char* xi_ = (unsigned char*)(wl + 1024);
        for (int it = gw; it < 4096; it += NGW) {
            const int c = it & 127, g = (it >> 7) & 15, b = it >> 11;
            float lbr, lbi, bre[16], bim[16], Lr, Li; s5_load((const float*)(PWS + WS_S5T), l, g, lane, lbr, lbi, Lr, Li, bre, bim);
            const int hcol = lane & 15, kq = lane >> 4;
            bf16x8v cb[4];
#pragma unroll
            for (int ks = 0; ks < 4; ++ks) { const size_t ci = ((size_t)((l * 16 + g) * 16 + hcol)) * 64 + 16 * ks + 4 * kq;
                const float4 cr = *(const float4*)(PIN(26) + ci), cm = *(const float4*)(PIN(27) + ci);
                union { unsigned u[4]; bf16x8v v; } pk; pk.u[0] = pk2(cr.x, -cm.x); pk.u[1] = pk2(cr.y, -cm.y); pk.u[2] = pk2(cr.z, -cm.z); pk.u[3] = pk2(cr.w, -cm.w); cb[ks] = pk.v; }
            float xr = 0.f, xi = 0.f;
            const float* sep = SE + ((size_t)(b * 16 + g) * 128 * 64 + lane) * 2;
            int j = 0;
            for (; j + 16 <= c; j += 16) { float2 eb[16];
#pragma unroll
                for (int q = 0; q < 16; ++q) eb[q] = *(const float2*)(sep + (size_t)(j + q) * 128);
#pragma unroll
                for (int q = 0; q < 16; ++q) { const float nxr = Lr * xr - Li * xi + eb[q].x, nxi = Lr * xi + Li * xr + eb[q].y; xr = nxr; xi = nxi; } }
            for (; j < c; ++j) { const float2 e = *(const float2*)(sep + (size_t)j * 128); const float nxr = Lr * xr - Li * xi + e.x, nxi = Lr * xi + Li * xr + e.y; xr = nxr; xi = nxi; }
            const float* up = U + (size_t)(b * SEQ + c * 64) * NINP + C_S5 + g * 16;
            const float dsk = PIN(28)[l * 256 + g * 16 + hcol];
            { const float4* ul = (const float4*)(up + (size_t)lane * NINP); const float4 a0 = ul[0], a1 = ul[1], a2 = ul[2], a3 = ul[3];
              float4* ud = (float4*)(us + lane * 16); ud[0] = a0; ud[1] = a1; ud[2] = a2; ud[3] = a3; }
            LDSW();
            for (int sc = 0; sc < 4; ++sc) {
#pragma unroll 4
                for (int s2 = 0; s2 < 16; ++s2) {
                    const float4* u4 = (const float4*)(us + (16 * sc + s2) * 16);
                    float bur = 0.f, bui = 0.f;
#pragma unroll
                    for (int q = 0; q < 4; ++q) { const float4 uv = u4[q];
                        bur += bre[4 * q] * uv.x + bre[4 * q + 1] * uv.y + bre[4 * q + 2] * uv.z + bre[4 * q + 3] * uv.w;
                        bui += bim[4 * q] * uv.x + bim[4 * q + 1] * uv.y + bim[4 * q + 2] * uv.z + bim[4 * q + 3] * uv.w; }
                    const float nxr = lbr * xr - lbi * xi + bur, nxi = lbr * xi + lbi * xr + bui; xr = nxr; xi = nxi;
                    *(unsigned*)(xi_ + s2 * 272 + 4 * lane) = cvtpk(xr, xi);
                }
                LDSW();
                f32x4v acc = (f32x4v){0.f, 0.f, 0.f, 0.f};
#pragma unroll
                for (int ks = 0; ks < 4; ++ks) { const bf16x8v af = *(const bf16x8v*)(xi_ + hcol * 272 + (32 * ks + 8 * kq) * 2);
                    acc = __builtin_amdgcn_mfma_f32_16x16x32_bf16(af, cb[ks], acc, 0, 0, 0); }
#pragma unroll
                for (int i = 0; i < 4; ++i) { const int srow = 16 * sc + 4 * kq + i;
                    const float y = gelu_t(acc[i] + dsk * us[srow * 16 + hcol]);
                    YS5[(size_t)(b * SEQ + c * 64 + srow) * 256 + g * 16 + hcol] = y; }
                LDSW();
            }
        }
    }
#endif
}

__device__ __forceinline__ void ph_post(const KP& p, int l, float* lds) {
    ZDEF;
    const int tid = ltid(), wave = __builtin_amdgcn_readfirstlane(tid >> 6), lane = tid & 63;
    const float* ON = (const float*)(PWS + WS_QN); const float* YS5 = (const float*)(PWS + WS_YS5);
    bf16* YMIX = (bf16*)(PWS + WS_XN);
    const float* onorm = PIN(10) + (size_t)l * DM;
    float* ys = lds; float* ob = lds + 32 * 260;
    bf16x8v gfr[16];
    { const bf16* gp = (const bf16*)(PWS + WS_GLUT) + (size_t)(32 * wave + (lane & 31)) * 256 + 8 * (lane >> 5);
#pragma unroll
      for (int ks = 0; ks < 16; ++ks) gfr[ks] = *(const bf16x8v*)(gp + 16 * ks); }
    for (int item = blockIdx.x; item < 512; item += gridDim.x) {
        const int row0 = item * 32;
#pragma unroll
        for (int q = 0; q < 4; ++q) { const size_t row = row0 + 4 * wave + q; const float4* op = (const float4*)(ON + row * 512);
            const float4 v0 = op[lane], v1 = op[64 + lane];
            const float ss = (v0.x * v0.x + v0.y * v0.y) + (v0.z * v0.z + v0.w * v0.w) + (v1.x * v1.x + v1.y * v1.y) + (v1.z * v1.z + v1.w * v1.w);
            const float rinv = rsqrtf(wsum(ss) * (1.0f / 512.0f) + EPSN);
            const float4 g0 = *(const float4*)(onorm + 256 + 4 * lane), g1 = *(const float4*)(onorm + 512 + 4 * lane);
            uint2 o0, o1; o0.x = pk2(v0.x * rinv * g0.x, v0.y * rinv * g0.y); o0.y = pk2(v0.z * rinv * g0.z, v0.w * rinv * g0.w);
            o1.x = pk2(v1.x * rinv * g1.x, v1.y * rinv * g1.y); o1.y = pk2(v1.z * rinv * g1.z, v1.w * rinv * g1.w);
            *(uint2*)(YMIX + row * DM + 256 + 4 * lane) = o0; *(uint2*)(YMIX + row * DM + 512 + 4 * lane) = o1; }
        for (int i = tid; i < 32 * 64; i += NTHR) { const int rr = i >> 6, c4 = i & 63; *(float4*)(ys + rr * 260 + 4 * c4) = ((const float4*)(YS5 + (size_t)row0 * 256))[i]; }
        __syncthreads();
        {
            const int ar = lane & 31, ah = lane >> 5;
            f32x16 acc;
#pragma unroll
            for (int i = 0; i < 16; ++i) acc[i] = 0.f;
#pragma unroll
            for (int ks = 0; ks < 16; ++ks) { const float4 f0 = *(const float4*)(ys + ar * 260 + 16 * ks + 8 * ah), f1 = *(const float4*)(ys + ar * 260 + 16 * ks + 8 * ah + 4);
                union { unsigned u[4]; bf16x8v v; } af; af.u[0] = pk2(f0.x, f0.y); af.u[1] = pk2(f0.z, f0.w); af.u[2] = pk2(f1.x, f1.y); af.u[3] = pk2(f1.z, f1.w);
                acc = __builtin_amdgcn_mfma_f32_32x32x16_bf16(af.v, gfr[ks], acc, 0, 0, 0); }
            const int n = 32 * wave + ar; const float gb = PIN(30)[l * 256 + n];
#pragma unroll
            for (int i = 0; i < 16; ++i) { const int rr = 8 * (i >> 2) + 4 * ah + (i & 3); const float yv = ys[rr * 260 + n]; ob[rr * 256 + n] = yv * sigm(acc[i] + gb); }
        }
        __syncthreads();
#pragma unroll
        for (int q = 0; q < 4; ++q) { const int tt = 4 * wave + q; float v[4]; float ss = 0.f;
#pragma unroll
            for (int jx = 0; jx < 4; ++jx) { v[jx] = ob[tt * 256 + lane + 64 * jx]; ss += v[jx] * v[jx]; }
            const float rinv = rsqrtf(wsum(ss) * (1.0f / 256.0f) + EPSN);
#pragma unroll
            for (int jx = 0; jx < 4; ++jx) YMIX[(size_t)(row0 + tt) * DM + 768 + lane + 64 * jx] = (bf16)f2bf(v[jx] * rinv * onorm[768 + lane + 64 * jx]); }
        __syncthreads();
    }
}


#define LAS __attribute__((address_space(3)))
#define XB_TMO      128
#define XB_XCNT(j)  (256  + 64 * (j))
#define XB_XSUB(j)  (1280 + 64 * (j))
#define XB_XGEN(j)  (2304 + 64 * (j))
#define XB_TOP      3328
#define XB_TOPGEN   3392
#define XCD_BAR_WORDS 3456
#define XB_SPIN_CAP (1u << 18)

__device__ __forceinline__ unsigned xb_ld(unsigned* p)              { return __hip_atomic_load(p, __ATOMIC_RELAXED, __HIP_MEMORY_SCOPE_AGENT); }
__device__ __forceinline__ unsigned xb_add(unsigned* p, unsigned v) { return __hip_atomic_fetch_add(p, v, __ATOMIC_RELAXED, __HIP_MEMORY_SCOPE_AGENT); }
__device__ __forceinline__ unsigned xb_xcc_id() { return (unsigned)__builtin_amdgcn_s_getreg((3 << 11) | 20) & 0xFu; }
#define XB_SPIN(cond, bar) do { unsigned _sp = 0; while (cond) { __builtin_amdgcn_s_sleep(1); \
    if ((++_sp & 255u) == 0u) { if (xb_ld(&(bar)[XB_TMO])) break; if (_sp > XB_SPIN_CAP) { atomicAdd(&(bar)[XB_TMO], 1u); break; } } } } while (0)

struct XcdBarrier {
    unsigned* bar; unsigned x;
    volatile LAS unsigned* st;
};

__device__ __forceinline__ XcdBarrier xcd_barrier_post(unsigned* bar, volatile LAS unsigned* st) {
    XcdBarrier b; b.bar = bar; b.x = xb_xcc_id(); b.st = st;
    if (threadIdx.x == 0) (void)xb_add(&bar[XB_XCNT(b.x)], 1u);
    return b;
}
__device__ __forceinline__ void xcd_barrier_complete(unsigned* bar, unsigned x, unsigned& nloc, unsigned& nx) {
    const unsigned G = gridDim.x * gridDim.y * gridDim.z;
    unsigned sum, cnt, mine, sp = 0u;
    for (;;) {
        sum = 0u; cnt = 0u; mine = 0u;
#pragma unroll
        for (unsigned j = 0; j < 16; ++j) { const unsigned c = xb_ld(&bar[XB_XCNT(j)]); sum += c; cnt += (c > 0u) ? 1u : 0u; mine = (j == x) ? c : mine; }
        if (sum == G) break;
        __builtin_amdgcn_s_sleep(1);
        if ((++sp & 255u) == 0u) { if (xb_ld(&bar[XB_TMO])) break; if (sp > XB_SPIN_CAP) { atomicAdd(&bar[XB_TMO], 1u); break; } }
    }
    nloc = mine > 0u ? mine : 1u; nx = cnt > 0u ? cnt : 1u;
}

__device__ __forceinline__ void xcd_barrier(const XcdBarrier& b) {
    asm volatile("s_waitcnt vmcnt(0)" ::: "memory");
    __syncthreads();
    if (threadIdx.x == 0) {
        unsigned* bar = b.bar;
        __builtin_amdgcn_s_waitcnt(0);
        unsigned nloc = b.st[0], nx = b.st[1];
        if (nloc == 0u) { xcd_barrier_complete(bar, b.x, nloc, nx); b.st[0] = nloc; b.st[1] = nx; }
        const unsigned old = xb_add(&bar[XB_XSUB(b.x)], 1u);
        const unsigned gen = old / nloc;
        if (old + 1u == (gen + 1u) * nloc) {
            __builtin_amdgcn_fence(__ATOMIC_RELEASE, "agent");
            asm volatile("s_waitcnt vmcnt(0)" ::: "memory");
            const unsigned og = xb_add(&bar[XB_TOP], 1u);
            const unsigned tg = og / nx;
            if (og + 1u == (tg + 1u) * nx) xb_add(&bar[XB_TOPGEN], 1u);
            else XB_SPIN(xb_ld(&bar[XB_TOPGEN]) == tg, bar);
            __builtin_amdgcn_fence(__ATOMIC_ACQUIRE, "agent");
            xb_add(&bar[XB_XGEN(b.x)], 1u);
            asm volatile("s_waitcnt vmcnt(0)" ::: "memory");
        } else {
            XB_SPIN(xb_ld(&bar[XB_XGEN(b.x)]) == gen, bar);
            __builtin_amdgcn_fence(__ATOMIC_ACQUIRE, "agent");
            asm volatile("s_waitcnt vmcnt(0)" ::: "memory");
        }
    }
    __syncthreads();
}
constexpr int NPHASE = 25;
#ifndef EN_MASK
#define EN_MASK 0xff
#endif
__global__ void __launch_bounds__(NTHR, 2) mk_fwd(KP p) {
    extern __shared__ __attribute__((aligned(16))) unsigned char smem[];
    cg::grid_group grid = cg::this_grid();
    float* ldsf = (float*)smem;
    PG8_LAS unsigned char* ldsl = (PG8_LAS unsigned char*)smem;
    volatile LAS unsigned* bst = (volatile LAS unsigned*)((LAS unsigned char*)smem + (LDS_BYTES - 128));
    if (threadIdx.x < 2) bst[threadIdx.x] = 0u;
    __syncthreads();
    XcdBarrier xbar = xcd_barrier_post((unsigned*)((unsigned char*)p.in[35] + WS_CTL), bst);
    for (int ph = p.ph_lo; ph < p.ph_hi; ++ph) {
        ZDEF;
        const float* modall = (const float*)(PWS + WS_MOD);
        bf16* XN = (bf16*)(PWS + WS_XN);
        int reps = 1;
#ifdef REPEAT_MASK
        { const int s_ = ph == 0 ? -1 : (ph - 1) % 12;
          const int bit = ph == 0 ? 1 : s_ == 0 ? 2 : (s_ == 3 || s_ == 9) ? 4 : s_ == 5 ? 8 : s_ == 6 ? 16 : s_ == 7 ? 32 : (s_ == 1 || s_ == 10) ? 64 : s_ == 4 ? 128 : 0;
          if (REPEAT_MASK & bit) reps = 2; }
#endif
        for (int rep = 0; rep < reps; ++rep) {
        const bool dry = (rep + 1 < reps);
        if (ph == 0) { if (EN_MASK & 1) ph_mod_rope(p, ldsf); ph_s5_table(p); }
        else {
            const int l = (ph - 1) / 12, s = (ph - 1) % 12;
            const float* modl = modall + (size_t)l * 2 * NMOD;
            const float* xin = (l == 0 && s <= 2) ? PIN(0) : POUT;
            if (s == 0) { if (EN_MASK & 2) ph_convert(p, l, ldsf); ph_norm(xin, PIN(4) + l * DM, modl, 0, XN); }
            else if (s == 3) { ph_norm(POUT, PIN(7) + l * DM, modl, 3, XN); }
            else if (s == 9) { ph_norm(POUT, PIN(31) + l * DM, modl, 6, XN); }
            else if ((EN_MASK & 4) && (s == 1 || s == 10)) {
                const int f = s == 1 ? 0 : 1;
                pg8::Gemm g{XN, (const bf16*)(PWS + WS_W1T) + (size_t)f * 2 * DFF * DM, MTOK, 2 * DFF, DM}; pg8::StaticOrder S; S.init(MTOK, 2 * DFF, gridDim.x, blockIdx.x);
                pg8::EpiSwiGLU E{(bf16*)(PWS + WS_A), DFF};
                pg8::gemm_phase<pg8::EpiSwiGLU, pg8::StaticOrder, true, true>(ldsl, g, S, E);
            }
            else if ((EN_MASK & 64) && (s == 2 || s == 11 || s == 8)) {
                const bf16* A = s == 8 ? (const bf16*)XN : (const bf16*)(PWS + WS_A);
                const bf16* Bt = s == 8 ? (const bf16*)(PWS + WS_WOUTT) : (const bf16*)(PWS + WS_W2T) + (size_t)(s == 2 ? 0 : 1) * DM * DFF;
                const int K = s == 8 ? DM : DFF;
                const int gi = s == 2 ? 2 : (s == 8 ? 5 : 8);
                pg8::Gemm g{A, Bt, MTOK, DM, K}; pg8::StaticOrder S; S.init(MTOK, DM, gridDim.x, blockIdx.x);
                pg8::EpiResid E{xin, POUT, modl + gi * DM, NMOD, s == 8 ? 1.0f : 0.5f, DM};
                pg8::gemm_phase<pg8::EpiResid, pg8::StaticOrder, true, true>(ldsl, g, S, E);
            }
            else if ((EN_MASK & 128) && s == 4) {
                pg8::Gemm g{XN, (const bf16*)(PWS + WS_WINT), MTOK, NINP, DM}; pg8::StaticOrder S; S.init(MTOK, NINP, gridDim.x, blockIdx.x);
                pg8::EpiF32 E{(float*)(PWS + WS_A), NINP};
                pg8::gemm_phase<pg8::EpiF32, pg8::StaticOrder, true, true>(ldsl, g, S, E);
            }
            else if ((EN_MASK & 8) && s == 5) { ph_mixA(p, l, ldsf); }
            else if ((EN_MASK & 16) && s == 6) {
#ifdef MIXB_DRY_PARTS
                ph_mixB(p, l, ldsf, dry, dry ? MIXB_DRY_PARTS : 3);
#else
                ph_mixB(p, l, ldsf, dry, 3);
#endif
            }
            else if ((EN_MASK & 32) && s == 7) { ph_post(p, l, ldsf); }
        }
        if (rep + 1 < reps) grid.sync();
        }
        if (ph + 1 < p.ph_hi) { if (ph == p.ph_lo) grid.sync(); else xcd_barrier(xbar); }
    }
}

extern "C" void kernel_launch(void* const* d_in, const int* in_sizes, int n_in, void* d_out, int out_size, void* d_ws, size_t ws_size, hipStream_t stream) {
    static int grid = 0;
    if (grid == 0) {
        if (n_in != 34 || out_size != MTOK * DM || ws_size < WS_END) { fprintf(stderr, "kernel_launch: unexpected shapes (n_in %d out %d ws %zu)\n", n_in, out_size, ws_size); grid = -1; return; }
        int dev = 0, cus = 0, per_cu = 0;
        hipGetDevice(&dev); hipDeviceGetAttribute(&cus, hipDeviceAttributeMultiprocessorCount, dev);
        if (hipFuncSetAttribute((const void*)mk_fwd, hipFuncAttributeMaxDynamicSharedMemorySize, LDS_BYTES) != hipSuccess) { fprintf(stderr, "kernel_launch: hipFuncSetAttribute failed\n"); }
        if (hipOccupancyMaxActiveBlocksPerMultiprocessor(&per_cu, (const void*)mk_fwd, NTHR, LDS_BYTES) != hipSuccess || per_cu < 1) { fprintf(stderr, "kernel_launch: occupancy query says %d\n", per_cu); per_cu = 1; }
        (void)hipGetLastError();
        grid = cus * 1;
        if (grid <= 0) grid = 256;
    }
    if (grid < 0) return;
    KP a{};
    for (int i = 0; i < 34; ++i) a.in[i] = (const float*)d_in[i];
    a.in[34] = (const float*)d_out; a.in[35] = (const float*)d_ws;
#if MK_MULTI
    for (int ph = 0; ph < NPHASE; ++ph) { a.ph_lo = ph; a.ph_hi = ph + 1; hipLaunchKernelGGL(mk_fwd, dim3(grid), dim3(NTHR), LDS_BYTES, stream, a); }
#else
    a.ph_lo = 0; a.ph_hi = NPHASE;
    if (hipMemsetAsync((unsigned char*)d_ws + WS_CTL, 0, CTL_BYTES, stream) != hipSuccess) fprintf(stderr, "kernel_launch: memset failed\n");
    void* args[] = {&a};
    hipError_t e = hipLaunchCooperativeKernel((const void*)mk_fwd, dim3(grid), dim3(NTHR), args, LDS_BYTES, stream);
    if (e != hipSuccess) fprintf(stderr, "kernel_launch: cooperative launch failed: %s (grid %d)\n", hipGetErrorString(e), grid);
#endif
}
```

```cpp
#include <hip/hip_runtime.h>
#include <hip/hip_cooperative_groups.h>
#include <cstdio>
#include <cstdint>
#include <cmath>
namespace pg8 {
#define PG8_LAS __attribute__((address_space(3)))
typedef unsigned short bf16_t;
typedef short bf16x8 __attribute__((ext_vector_type(8)));
typedef float f32x4 __attribute__((ext_vector_type(4)));
typedef unsigned u32x4 __attribute__((ext_vector_type(4)));
constexpr int BM = 256, BK = 64, HALF = 128, HTB = HALF * BK * 2  , STAGE_BYTES = 8 * HTB, NXCD = 8, WGM = 8;

__host__ __device__ __forceinline__ int lds_byte(int r, int c) { const int st = (r >> 4) * 2 + (c >> 5), rr = r & 15, cc = c & 31, ob = rr * 64 + cc * 2; return st * 1024 + (ob ^ (((ob >> 9) & 1) << 5)); }
__host__ __device__ __forceinline__ void stage_rc(int b, int& R, int& C) { const int st = b / 1024, sb = b % 1024, swz = sb ^ (((sb >> 9) & 1) << 5); R = (st >> 1) * 16 + swz / 64; C = (st & 1) * 32 + (swz % 64) / 2; }
__host__ __device__ __forceinline__ int perm32(int rho) { const int n = rho >> 4, i = rho & 15; return 8 * (i >> 2) + 4 * n + (i & 3); }

struct Unit { int pm, pn; };
struct Gemm { const bf16_t* A; const bf16_t* Bt; int M, N, K; };

struct StaticOrder {
    int nM, nN, nwg, G, c;
    __host__ __device__ void init(int M, int N, int G_, int c_) { nM = M / BM; nN = N / BM; nwg = nM * nN; G = G_; c = c_; }
    __host__ __device__ bool next(int i, Unit& u) const {
        const long L = (long)i * G + c; if (L >= nwg) return false;
        int wgid = (int)L; { const int q = nwg / NXCD, r = nwg % NXCD, xcd = wgid % NXCD, off = wgid / NXCD; wgid = (xcd < r ? xcd * (q + 1) : r * (q + 1) + (xcd - r) * q) + off; }
        const int nig = WGM * nN, gid = wgid / nig, fm = gid * WGM, gsz = (nM - fm) < WGM ? (nM - fm) : WGM;
        u.pm = fm + ((wgid % nig) % gsz); u.pn = (wgid % nig) / gsz; return true;
    }
    __device__ __forceinline__ void a_ready(const Unit&) const {}
    __device__ __forceinline__ void done(const Unit&) const {}
};

__device__ __forceinline__ unsigned cvt_pk_bf16(float lo, float hi) { unsigned r; asm volatile("v_cvt_pk_bf16_f32 %0, %1, %2" : "=v"(r) : "v"(lo), "v"(hi)); return r; }
typedef float f32x2 __attribute__((ext_vector_type(2)));
struct EpiSwiGLU {
    static constexpr bool PERM = true, AFTER_DRAIN = false;
    bf16_t* H; int ldh;
    __device__ __forceinline__ void operator()(const f32x4 (&acc)[2][2][4][2], const Unit& u, int wr, int wc, int fr, int fq) const {
        const int row0 = u.pm * BM + wr * 64 + fr; const int col0 = u.pn * HALF + wc * 32 + 8 * fq;
#pragma unroll
        for (int ai = 0; ai < 2; ++ai)
#pragma unroll
            for (int m = 0; m < 4; ++m) { bf16_t* rowp = H + (size_t)(row0 + ai * HALF + m * 16) * ldh + col0;
                float h[8];
#pragma unroll
                for (int n = 0; n < 2; ++n)
#pragma unroll
                    for (int i = 0; i < 4; ++i) { const float g = acc[ai][0][m][n][i], up = acc[ai][1][m][n][i]; h[4 * n + i] = g * up * __builtin_amdgcn_rcpf(1.0f + __expf(-g)); }
                u32x4 w; w.x = cvt_pk_bf16(h[0], h[1]); w.y = cvt_pk_bf16(h[2], h[3]); w.z = cvt_pk_bf16(h[4], h[5]); w.w = cvt_pk_bf16(h[6], h[7]);
                *(u32x4*)rowp = w; }
    }
};
struct EpiResid {
    static constexpr bool PERM = false, AFTER_DRAIN = false;
    const float* base; float* out; const float* gate; int gstride; float coef; int ldc;
    __device__ __forceinline__ void operator()(const f32x4 (&acc)[2][2][4][2], const Unit& u, int wr, int wc, int fr, int fq) const {
        const int b = (u.pm * BM) >> 13; const float* gp = gate + (size_t)b * gstride;
        const int col0 = u.pn * BM + wc * 32 + 4 * fq;
        f32x4 gv[2][2];
#pragma unroll
        for (int bj = 0; bj < 2; ++bj)
#pragma unroll
            for (int n = 0; n < 2; ++n) gv[bj][n] = *(const f32x4*)(gp + col0 + bj * HALF + n * 16) * coef;
#pragma unroll
        for (int ai = 0; ai < 2; ++ai)
#pragma unroll
            for (int m = 0; m < 4; ++m) { const size_t off = (size_t)(u.pm * BM + ai * HALF + wr * 64 + m * 16 + fr) * ldc + col0;
#pragma unroll
                for (int bj = 0; bj < 2; ++bj)
#pragma unroll
                    for (int n = 0; n < 2; ++n) { const f32x4 bs = *(const f32x4*)(base + off + bj * HALF + n * 16);
                        *(f32x4*)(out + off + bj * HALF + n * 16) = bs + gv[bj][n] * acc[ai][bj][m][n]; }
                asm volatile("" ::: "memory"); }
    }
};
struct EpiF32 {
    static constexpr bool PERM = false, AFTER_DRAIN = false;
    float* O; int ldc;
    __device__ __forceinline__ void operator()(const f32x4 (&acc)[2][2][4][2], const Unit& u, int wr, int wc, int fr, int fq) const {
        const int col0 = u.pn * BM + wc * 32 + 4 * fq;
#pragma unroll
        for (int ai = 0; ai < 2; ++ai)
#pragma unroll
            for (int m = 0; m < 4; ++m) { const size_t off = (size_t)(u.pm * BM + ai * HALF + wr * 64 + m * 16 + fr) * ldc + col0;
#pragma unroll
                for (int bj = 0; bj < 2; ++bj)
#pragma unroll
                    for (int n = 0; n < 2; ++n) *(f32x4*)(O + off + bj * HALF + n * 16) = acc[ai][bj][m][n];
                asm volatile("" ::: "memory"); }
    }
};
template <class Epi, class Sched, bool ALIGN_EPI = false, bool SP2 = false>
__device__ __forceinline__ void gemm_phase(PG8_LAS unsigned char* lds, const Gemm g, const Sched& S, const Epi& E) {
    int tid_ = threadIdx.x; asm volatile("" : "+v"(tid_)); const int tid = tid_, wid = __builtin_amdgcn_readfirstlane(tid >> 6), lane = tid & 63, wr = wid >> 2, wc = wid & 3, fr = lane & 15, fq = lane >> 4;
    const int K = g.K, nt = K / BK;
    unsigned voffA[2], voffB[2];
#pragma unroll
    for (int i = 0; i < 2; ++i) { int R, C; stage_rc(tid * 16 + i * 8192, R, C); const int Rb = Epi::PERM ? ((R & ~31) + perm32(R & 31)) : R;
        voffA[i] = (unsigned)(R * K + C) * 2u; voffB[i] = (unsigned)(Rb * K + C) * 2u; }
    const size_t kstep = (size_t)(BK * 2);
    const size_t hstep = (size_t)HALF * K * 2;
    const size_t tstep = 2 * hstep;
    const unsigned ldsw = (unsigned)wid * 1024u;
    const int aoff = lds_byte(wr * 64 + fr, fq * 8), boff = lds_byte(wc * 32 + fr, fq * 8);
#define PG8_SA(b, h) (((b) * 2 + (h)) * HTB)
#define PG8_SB(b, h) ((4 + (b) * 2 + (h)) * HTB)
#define PG8_STAGE(bufoff, gbase, voff) do { _Pragma("unroll") for (int _i = 0; _i < 2; ++_i) \
        __builtin_amdgcn_global_load_lds((const unsigned*)((const char*)(gbase) + (voff)[_i]), (PG8_LAS unsigned*)(lds + (bufoff) + ldsw + _i * 8192), 16, 0, 0); } while (0)
#define PG8_LDA(dst, b, h) do { _Pragma("unroll") for (int m = 0; m < 4; ++m) _Pragma("unroll") for (int k = 0; k < 2; ++k) dst[m][k] = *(const PG8_LAS bf16x8*)(lds + PG8_SA(b, h) + aoff + m * 2048 + k * 1024); } while (0)
#define PG8_LDB(dst, b, h) do { _Pragma("unroll") for (int n = 0; n < 2; ++n) _Pragma("unroll") for (int k = 0; k < 2; ++k) dst[n][k] = *(const PG8_LAS bf16x8*)(lds + PG8_SB(b, h) + boff + n * 2048 + k * 1024); } while (0)
#define PG8_MMA(ai, bj, At, Bt) do { __builtin_amdgcn_s_setprio(1); _Pragma("unroll") for (int m = 0; m < 4; ++m) _Pragma("unroll") for (int n = 0; n < 2; ++n) _Pragma("unroll") for (int k = 0; k < 2; ++k) \
        acc[ai][bj][m][n] = __builtin_amdgcn_mfma_f32_16x16x32_bf16(Bt[n][k], At[m][k], acc[ai][bj][m][n], 0, 0, 0); __builtin_amdgcn_s_setprio(0); } while (0)
#define PG8_WAIT_V(n) asm volatile("s_waitcnt vmcnt(" #n ")" ::: "memory")
#define PG8_WAIT_L(n) asm volatile("s_waitcnt lgkmcnt(" #n ")" ::: "memory")
#define PG8_BAR __builtin_amdgcn_s_barrier()
#define PG8_SCHED __builtin_amdgcn_sched_barrier(0)
    Unit cur, nxt; int ui = 0;
    if (!S.next(0, cur)) return;
    f32x4 acc[2][2][4][2];
#pragma unroll
    for (int a = 0; a < 2; ++a)
#pragma unroll
        for (int b = 0; b < 2; ++b)
#pragma unroll
            for (int m = 0; m < 4; ++m)
#pragma unroll
                for (int n = 0; n < 2; ++n) acc[a][b][m][n] = (f32x4){0.f, 0.f, 0.f, 0.f};
    bf16x8 At[4][2], B0[2][2], B1[2][2];
    const char* cA = (const char*)g.A + (size_t)cur.pm * tstep; const char* cB = (const char*)g.Bt + (size_t)cur.pn * tstep;
    S.a_ready(cur);
    if constexpr (SP2) {
        PG8_STAGE(PG8_SB(0, 0), cB, voffB); PG8_STAGE(PG8_SB(0, 1), cB + hstep, voffB); PG8_STAGE(PG8_SA(0, 0), cA, voffA); PG8_STAGE(PG8_SA(0, 1), cA + hstep, voffA);
        if (wr == 1) PG8_BAR;
        PG8_WAIT_V(2); PG8_BAR;
        PG8_STAGE(PG8_SB(1, 0), cB + kstep, voffB); PG8_STAGE(PG8_SA(1, 0), cA + kstep, voffA); PG8_STAGE(PG8_SB(1, 1), cB + hstep + kstep, voffB);
        PG8_WAIT_V(6); PG8_BAR;
    } else {
        PG8_STAGE(PG8_SB(0, 0), cB, voffB); PG8_STAGE(PG8_SA(0, 0), cA, voffA); PG8_STAGE(PG8_SB(0, 1), cB + hstep, voffB); PG8_STAGE(PG8_SA(0, 1), cA + hstep, voffA);
        if (wr == 1) PG8_BAR;
        PG8_WAIT_V(4); PG8_BAR;
        PG8_STAGE(PG8_SB(1, 0), cB + kstep, voffB); PG8_STAGE(PG8_SA(1, 0), cA + kstep, voffA); PG8_STAGE(PG8_SB(1, 1), cB + hstep + kstep, voffB);
        PG8_WAIT_V(6); PG8_BAR;
    }
    for (;;) {
        const bool has_next = S.next(ui + 1, nxt);
        const char* nA = has_next ? (const char*)g.A + (size_t)nxt.pm * tstep : cA; const char* nB = has_next ? (const char*)g.Bt + (size_t)nxt.pn * tstep : cB;
        for (int t = 0; t < nt; t += 2) {
            const bool last = (t == nt - 2);
            const char* a1 = cA + (size_t)(t + 1) * kstep;
            const char* a2 = last ? nA : cA + (size_t)(t + 2) * kstep; const char* b2 = last ? nB : cB + (size_t)(t + 2) * kstep;
            const char* a3 = a2 + kstep; const char* b3 = b2 + kstep;
            if (last && has_next) S.a_ready(nxt);
            if constexpr (SP2) {
            PG8_LDB(B0, 0, 0); PG8_LDB(B1, 0, 1); PG8_SCHED; PG8_LDA(At, 0, 0); PG8_STAGE(PG8_SA(1, 1), a1 + hstep, voffA);
            PG8_WAIT_V(8); PG8_WAIT_L(0); PG8_BAR; PG8_MMA(0, 0, At, B0); PG8_MMA(0, 1, At, B1); PG8_BAR; PG8_SCHED;
            PG8_LDA(At, 0, 1); PG8_STAGE(PG8_SB(0, 0), b2, voffB); PG8_STAGE(PG8_SB(0, 1), b2 + hstep, voffB); PG8_STAGE(PG8_SA(0, 0), a2, voffA);
            PG8_WAIT_V(8); PG8_WAIT_L(0); PG8_BAR; PG8_MMA(1, 0, At, B0); PG8_MMA(1, 1, At, B1); PG8_BAR; PG8_SCHED;
            PG8_LDB(B0, 1, 0); PG8_LDB(B1, 1, 1); PG8_SCHED; PG8_LDA(At, 1, 0); PG8_STAGE(PG8_SA(0, 1), a2 + hstep, voffA);
            PG8_WAIT_V(8); PG8_WAIT_L(0); PG8_BAR; PG8_MMA(0, 0, At, B0); PG8_MMA(0, 1, At, B1); PG8_BAR; PG8_SCHED;
            PG8_LDA(At, 1, 1); PG8_STAGE(PG8_SB(1, 0), b3, voffB); PG8_STAGE(PG8_SB(1, 1), b3 + hstep, voffB); PG8_STAGE(PG8_SA(1, 0), a3, voffA);
            PG8_WAIT_V(8); PG8_WAIT_L(0); PG8_BAR; PG8_MMA(1, 0, At, B0); PG8_MMA(1, 1, At, B1); PG8_BAR; PG8_SCHED;
            } else {
            PG8_LDB(B0, 0, 0); PG8_SCHED; PG8_LDA(At, 0, 0); PG8_STAGE(PG8_SA(1, 1), a1 + hstep, voffA);
            PG8_WAIT_L(8); PG8_BAR; PG8_WAIT_L(0); PG8_MMA(0, 0, At, B0); PG8_BAR; PG8_SCHED;
            PG8_LDB(B1, 0, 1); PG8_STAGE(PG8_SB(0, 0), b2, voffB);
            PG8_BAR; PG8_WAIT_L(0); PG8_MMA(0, 1, At, B1); PG8_BAR;
            PG8_LDA(At, 0, 1); PG8_STAGE(PG8_SA(0, 0), a2, voffA);
            PG8_BAR; PG8_WAIT_L(0); PG8_MMA(1, 0, At, B0); PG8_BAR; PG8_SCHED;
            PG8_STAGE(PG8_SB(0, 1), b2 + hstep, voffB);
            PG8_WAIT_V(6); PG8_BAR; PG8_MMA(1, 1, At, B1); PG8_BAR;
            PG8_LDB(B0, 1, 0); PG8_SCHED; PG8_LDA(At, 1, 0); PG8_STAGE(PG8_SA(0, 1), a2 + hstep, voffA);
            PG8_WAIT_L(8); PG8_BAR; PG8_WAIT_L(0); PG8_MMA(0, 0, At, B0); PG8_BAR; PG8_SCHED;
            PG8_LDB(B1, 1, 1); PG8_STAGE(PG8_SB(1, 0), b3, voffB);
            PG8_BAR; PG8_WAIT_L(0); PG8_MMA(0, 1, At, B1); PG8_BAR;
            PG8_LDA(At, 1, 1); PG8_STAGE(PG8_SA(1, 0), a3, voffA);
            PG8_BAR; PG8_WAIT_L(0); PG8_MMA(1, 0, At, B0); PG8_BAR; PG8_SCHED;
            PG8_STAGE(PG8_SB(1, 1), b3 + hstep, voffB);
            PG8_WAIT_V(6); PG8_BAR; PG8_MMA(1, 1, At, B1); PG8_BAR;
            }
        }
        if constexpr (ALIGN_EPI) { if (wr == 0) PG8_BAR; }
        if constexpr (!Epi::AFTER_DRAIN) { E(acc, cur, wr, wc, fr, fq); S.done(cur); }
        if (!has_next) break;
#pragma unroll
        for (int a = 0; a < 2; ++a)
#pragma unroll
            for (int b = 0; b < 2; ++b)
#pragma unroll
                for (int m = 0; m < 4; ++m)
#pragma unroll
                    for (int n = 0; n < 2; ++n) acc[a][b][m][n] = (f32x4){0.f, 0.f, 0.f, 0.f};
        cur = nxt; cA = nA; cB = nB; ++ui;
        if constexpr (ALIGN_EPI) { if (wr == 1) PG8_BAR; }
    }
    PG8_WAIT_V(0);
    if constexpr (!ALIGN_EPI) { if (wr == 0) PG8_BAR; }
    PG8_BAR;
    if constexpr (Epi::AFTER_DRAIN) { E.fused(acc, cur, wr, wc, fr, fq, lds, wid, lane); S.done(cur); }
#undef PG8_SA
#undef PG8_SB
#undef PG8_STAGE
#undef PG8_LDA
#undef PG8_LDB
#undef PG8_MMA
#undef PG8_WAIT_V
#undef PG8_WAIT_L
#undef PG8_BAR
#undef PG8_SCHED
}
}

namespace cg = cooperative_groups;
typedef unsigned short bf16;
typedef float f32x16 __attribute__((ext_vector_type(16)));
typedef short bf16x8v __attribute__((ext_vector_type(8)));
constexpr int NWV = 8, NTHR = 512;
constexpr int SEQ = 8192, DM = 1024, MTOK = 16384, DFF = 2816, NIN = 1816, NINP = 2048, NMOD = 9216;
constexpr int C_Q = 256, C_KC = 768, C_KS = 1024, C_VS = 1152, C_KW = 1280, C_VW = 1408, C_GATE = 1536, C_S5 = 1560;
constexpr float EPSN = 1e-6f;
constexpr size_t MiB = 1u << 20;
constexpr size_t WS_A = 0;
constexpr size_t WS_XN = 128 * MiB;
constexpr size_t WS_W1T = 160 * MiB;
constexpr size_t WS_W2T = 182 * MiB;
constexpr size_t WS_WINT = 193 * MiB;
constexpr size_t WS_WOUTT = 197 * MiB;
constexpr size_t WS_QN = 200 * MiB;
constexpr size_t WS_KS = 232 * MiB;
constexpr size_t WS_KW = 240 * MiB;
constexpr size_t WS_YS5 = 248 * MiB;
constexpr size_t WS_MOD = 264 * MiB;
constexpr size_t WS_ROPE = 265 * MiB;
constexpr size_t WS_KCMP = 266 * MiB;
constexpr size_t WS_VCMP = 266 * MiB + 512 * 1024;
constexpr size_t WS_S5END = 267 * MiB;
constexpr size_t WS_VTS = 269 * MiB;
constexpr size_t WS_VTW = 273 * MiB;
constexpr size_t WS_VTC = 277 * MiB;
constexpr size_t WS_CTL = 278 * MiB;
constexpr size_t CTL_BYTES = 16384;
constexpr size_t WS_WCT = 279 * MiB;
constexpr size_t WS_GLUT = 280 * MiB;
constexpr size_t WS_S5T = 281 * MiB;
constexpr size_t WS_END = 282 * MiB;
constexpr int LDS_BYTES = 147456;

struct KP { const float* in[36]; int ph_lo, ph_hi; };
#define PIN(i) (p.in[(i) + z_])
#define PWS ((unsigned char*)p.in[35 + z_])
#define POUT ((float*)p.in[34 + z_])
#define ZDEF int z_ = 0; asm volatile("" : "+s"(z_))

__device__ __forceinline__ float wsum(float v) {
#define DPPADD_(ctrl, rmask) { const int t_ = __builtin_amdgcn_update_dpp(0, __float_as_int(v), ctrl, rmask, 0xf, false); v += __int_as_float(t_); }
    DPPADD_(0x111, 0xf) DPPADD_(0x112, 0xf) DPPADD_(0x114, 0xf) DPPADD_(0x118, 0xf) DPPADD_(0x142, 0xa) DPPADD_(0x143, 0xc)
#undef DPPADD_
    return __int_as_float(__builtin_amdgcn_readlane(__float_as_int(v), 63));
}
__device__ __forceinline__ float qsum(float v) {
    v += __int_as_float(__builtin_amdgcn_mov_dpp(__float_as_int(v), 0xB1, 0xf, 0xf, true));
    v += __int_as_float(__builtin_amdgcn_mov_dpp(__float_as_int(v), 0x4E, 0xf, 0xf, true));
    return v;
}
__device__ __forceinline__ float wmax(float v) {
#pragma unroll
    for (int o = 32; o > 0; o >>= 1) v = fmaxf(v, __shfl_xor(v, o));
    return v;
}
__device__ __forceinline__ unsigned f2bf(float f) { unsigned u = __builtin_bit_cast(unsigned, f); return (u + 0x7fffu + ((u >> 16) & 1u)) >> 16; }
__device__ __forceinline__ unsigned pk2(float lo, float hi) { return f2bf(lo) | (f2bf(hi) << 16); }
__device__ __forceinline__ float gelu_t(float x) { const float z = 1.5957691216057308f * (x + 0.044715f * x * x * x); return x * __builtin_amdgcn_rcpf(1.0f + __expf(-z)); }
__device__ __forceinline__ float sigm(float x) { return __builtin_amdgcn_rcpf(1.0f + __expf(-x)); }
__device__ __forceinline__ int ltid() { int t = threadIdx.x; asm volatile("" : "+v"(t)); return t; }

__device__ __forceinline__ float wave_max_dpp(float v) {
#define DPPMAX_(ctrl, rmask) { const int t_ = __builtin_amdgcn_update_dpp((int)0xff800000, __float_as_int(v), ctrl, rmask, 0xf, false); v = fmaxf(v, __int_as_float(t_)); }
    DPPMAX_(0x111, 0xf) DPPMAX_(0x112, 0xf) DPPMAX_(0x114, 0xf) DPPMAX_(0x118, 0xf) DPPMAX_(0x142, 0xa) DPPMAX_(0x143, 0xc)
#undef DPPMAX_
    return __int_as_float(__builtin_amdgcn_readlane(__float_as_int(v), 63));
}
#define LDSW() asm volatile("s_waitcnt lgkmcnt(0)" ::: "memory")

__device__ __forceinline__ void ph_mod_rope(const KP& p, float* lds) {
    ZDEF;
    const int tid = ltid(), wave = __builtin_amdgcn_readfirstlane(tid >> 6), lane = tid & 63;
    for (int i = tid; i < 2048; i += NTHR) { const float c = PIN(1)[i]; lds[i] = c / (1.0f + expf(-c)); }
    __syncthreads();
    float* red = lds + 2048;
    float* mod = (float*)(PWS + WS_MOD);
    for (int item = blockIdx.x; item < 144; item += gridDim.x) {
        const int l = item / 72, n0 = (item % 72) * 128;
        const float* W = PIN(2) + (size_t)l * 1024 * NMOD + n0 + 2 * lane;
        float a00 = 0.f, a01 = 0.f, a10 = 0.f, a11 = 0.f;
#pragma unroll 16
        for (int kk = 0; kk < 128; ++kk) { const int k = wave * 128 + kk; const float2 w = *(const float2*)(W + (size_t)k * NMOD); const float s0 = lds[k], s1 = lds[1024 + k];
            a00 += s0 * w.x; a01 += s0 * w.y; a10 += s1 * w.x; a11 += s1 * w.y; }
        red[(wave * 2 + 0) * 128 + 2 * lane] = a00; red[(wave * 2 + 0) * 128 + 2 * lane + 1] = a01;
        red[(wave * 2 + 1) * 128 + 2 * lane] = a10; red[(wave * 2 + 1) * 128 + 2 * lane + 1] = a11;
        __syncthreads();
        if (tid < 256) { const int b = tid >> 7, n = tid & 127; float s = 0.f;
#pragma unroll
            for (int w = 0; w < 8; ++w) s += red[(w * 2 + b) * 128 + n];
            mod[(size_t)(l * 2 + b) * NMOD + n0 + n] = s + PIN(3)[l * NMOD + n0 + n]; }
        __syncthreads();
    }
    const int gid = blockIdx.x * NTHR + tid;
    if (gid < SEQ * 8) { const int s = gid >> 3, i = gid & 7;
        const float inv = expf(-13.122363377404328f * (float)i * 0.125f); const float ang = (float)s * inv;
        float sn, cs; sincosf(ang, &sn, &cs);
        float* rope = (float*)(PWS + WS_ROPE); rope[s * 16 + i] = cs; rope[s * 16 + 8 + i] = sn; }
}

template <int MODE> __device__ __forceinline__ void cvt_item(const float* W, int K, int N, bf16* WT, float* scr, int item, int lane) {
    const int nblk = (N + 31) / 32, kb = item / nblk, nb = item % nblk, k0 = 64 * kb, n0 = 32 * nb;
    const int nn = n0 + (lane & 31);
#pragma unroll 32
    for (int i = 0; i < 32; ++i) { const int kk = 2 * i + (lane >> 5); scr[kk * 33 + (lane & 31)] = (nn < N) ? W[(size_t)(k0 + kk) * N + nn] : 0.f; }
    LDSW();
    const int c = lane & 7;
#pragma unroll
    for (int j = 0; j < 4; ++j) { const int nl = (lane >> 3) + 8 * j, n = n0 + nl; const float* s = scr + (8 * c) * 33 + nl;
        uint4 o; o.x = pk2(s[0 * 33], s[1 * 33]); o.y = pk2(s[2 * 33], s[3 * 33]); o.z = pk2(s[4 * 33], s[5 * 33]); o.w = pk2(s[6 * 33], s[7 * 33]);
        int row = n;
        if (MODE == 1) { const int up = n >= DFF ? 1 : 0, n2 = n - up * DFF; row = 256 * (n2 >> 7) + (n2 & 127) + 128 * up; }
        if (n < N) *(uint4*)(WT + (size_t)row * K + k0 + 8 * c) = o; }
    LDSW();
}

__device__ __forceinline__ void ph_convert(const KP& p, int l, float* lds) {
    ZDEF;
    const int tid = ltid(), wave = __builtin_amdgcn_readfirstlane(tid >> 6), lane = tid & 63;
    const int gw = blockIdx.x * NWV + wave, NGW = gridDim.x * NWV;
    float* scr = lds + wave * (64 * 33 + 16);
    constexpr int I_1 = 16 * 176, I_2 = 44 * 32, I_IN = 16 * 57, I_OUT = 16 * 32, I_Z = 232 * 2;
    constexpr int I_C = 32 * 4;
    constexpr int I_G = 4 * 8;
    constexpr int NITEMS = 2 * I_1 + 2 * I_2 + I_IN + I_OUT + I_Z + 2 * I_C + I_G;
    bf16* W1T = (bf16*)(PWS + WS_W1T); bf16* W2T = (bf16*)(PWS + WS_W2T); bf16* WINT = (bf16*)(PWS + WS_WINT); bf16* WOUTT = (bf16*)(PWS + WS_WOUTT);
    for (int it = gw; it < NITEMS; it += NGW) {
        int r = it;
        if (r < I_1) { cvt_item<1>(PIN(5) + (size_t)l * DM * 2 * DFF, DM, 2 * DFF, W1T, scr, r, lane); continue; } r -= I_1;
        if (r < I_1) { cvt_item<1>(PIN(32) + (size_t)l * DM * 2 * DFF, DM, 2 * DFF, W1T + (size_t)2 * DFF * DM, scr, r, lane); continue; } r -= I_1;
        if (r < I_2) { cvt_item<0>(PIN(6) + (size_t)l * DFF * DM, DFF, DM, W2T, scr, r, lane); continue; } r -= I_2;
        if (r < I_2) { cvt_item<0>(PIN(33) + (size_t)l * DFF * DM, DFF, DM, W2T + (size_t)DM * DFF, scr, r, lane); continue; } r -= I_2;
        if (r < I_IN) { cvt_item<0>(PIN(8) + (size_t)l * DM * NIN, DM, NIN, WINT, scr, r, lane); continue; } r -= I_IN;
        if (r < I_OUT) { cvt_item<0>(PIN(9) + (size_t)l * DM * DM, DM, DM, WOUTT, scr, r, lane); continue; } r -= I_OUT;
        if (r >= I_Z + 2 * I_C) { r -= I_Z + 2 * I_C; cvt_item<0>(PIN(29) + (size_t)l * 65536, 256, 256, (bf16*)(PWS + WS_GLUT), scr, r, lane); continue; }
        if (r >= I_Z) { r -= I_Z; const int kvx = r >= I_C ? 1 : 0; r -= kvx * I_C;
            cvt_item<0>((kvx ? PIN(19) : PIN(17)) + (size_t)l * 2048 * 128, 2048, 128, (bf16*)(PWS + WS_WCT) + (size_t)kvx * 128 * 2048, scr, r, lane); continue; }
        { const int row = NIN + (r >> 1), half = r & 1; *(uint4*)(WINT + (size_t)row * DM + half * 512 + lane * 8) = make_uint4((unsigned)z_, (unsigned)z_, (unsigned)z_, (unsigned)z_); }
    }
}

__device__ __forceinline__ void ph_norm(const float* x, const float* gain, const float* modl, int ish, bf16* XN) {
    const int tid = ltid(), wave = __builtin_amdgcn_readfirstlane(tid >> 6), lane = tid & 63;
    const int gw = blockIdx.x * NWV + wave, NGW = gridDim.x * NWV;
    for (int m = gw; m < MTOK; m += NGW) {
        const int b = m >> 13;
        const float4* xr = (const float4*)(x + (size_t)m * DM) + lane;
        float4 v[4]; float ss = 0.f;
#pragma unroll
        for (int j = 0; j < 4; ++j) { v[j] = xr[64 * j]; ss += (v[j].x * v[j].x + v[j].y * v[j].y) + (v[j].z * v[j].z + v[j].w * v[j].w); }
        const float rinv = rsqrtf(wsum(ss) * (1.0f / DM) + EPSN);
        const float* sh = modl + (size_t)b * NMOD + ish * DM; const float* sc = sh + DM;
#pragma unroll
        for (int j = 0; j < 4; ++j) { const int col = 4 * lane + 256 * j;
            const float4 g4 = *(const float4*)(gain + col), s4 = *(const float4*)(sc + col), h4 = *(const float4*)(sh + col);
            const float o0 = v[j].x * rinv * g4.x * (1.0f + s4.x) + h4.x, o1 = v[j].y * rinv * g4.y * (1.0f + s4.y) + h4.y;
            const float o2 = v[j].z * rinv * g4.z * (1.0f + s4.z) + h4.z, o3 = v[j].w * rinv * g4.w * (1.0f + s4.w) + h4.w;
            uint2 o; o.x = pk2(o0, o1); o.y = pk2(o2, o3); *(uint2*)(XN + (size_t)m * DM + col) = o; }
    }
}

__device__ __forceinline__ void s5_setup(const KP& p, int l, int g, int lane, float& lbr, float& lbi, float (&bre)[16], float (&bim)[16], float& are, float& aim) {
    ZDEF;
    const float lre = PIN(21)[l * 1024 + g * 64 + lane], lim = PIN(22)[l * 1024 + g * 64 + lane], step = expf(PIN(23)[l * 16 + g]);
    are = lre * step; aim = lim * step;
    const float em1 = expm1f(are), e = em1 + 1.0f; float sn, cs; sincosf(aim, &sn, &cs);
    float sh, chh; sincosf(0.5f * aim, &sh, &chh);
    lbr = e * cs; lbi = e * sn;
    const float nr = em1 * cs - 2.0f * sh * sh, ni = lbi;
    const float den = 1.0f / (lre * lre + lim * lim);
    const float cr = (nr * lre + ni * lim) * den, ci = (ni * lre - nr * lim) * den;
    const float4* br4 = (const float4*)(PIN(24) + ((size_t)(l * 16 + g) * 64 + lane) * 16);
    const float4* bi4 = (const float4*)(PIN(25) + ((size_t)(l * 16 + g) * 64 + lane) * 16);
#pragma unroll
    for (int q = 0; q < 4; ++q) { const float4 a = br4[q], c = bi4[q];
        bre[4 * q + 0] = a.x * cr - c.x * ci; bim[4 * q + 0] = a.x * ci + c.x * cr;
        bre[4 * q + 1] = a.y * cr - c.y * ci; bim[4 * q + 1] = a.y * ci + c.y * cr;
        bre[4 * q + 2] = a.z * cr - c.z * ci; bim[4 * q + 2] = a.z * ci + c.z * cr;
        bre[4 * q + 3] = a.w * cr - c.w * ci; bim[4 * q + 3] = a.w * ci + c.w * cr; }
}

__device__ __forceinline__ void ph_s5_table(const KP& p) {
    ZDEF;
    const int tid = ltid();
    const int gid = blockIdx.x * NTHR + tid;
    if (gid < 2048) { const int l = gid >> 10, g = (gid >> 6) & 15, lane = gid & 63;
        float lbr, lbi, bre[16], bim[16], are, aim; s5_setup(p, l, g, lane, lbr, lbi, bre, bim, are, aim);
        float Lr, Li; { const float e = expf(are * 64.0f); float sn, cs; sincosf(aim * 64.0f, &sn, &cs); Lr = e * cs; Li = e * sn; }
        float4* tp = (float4*)((float*)(PWS + WS_S5T) + (size_t)gid * 36);
        tp[0] = make_float4(lbr, lbi, Lr, Li);
#pragma unroll
        for (int q = 0; q < 4; ++q) { tp[1 + q] = make_float4(bre[4 * q], bre[4 * q + 1], bre[4 * q + 2], bre[4 * q + 3]); tp[5 + q] = make_float4(bim[4 * q], bim[4 * q + 1], bim[4 * q + 2], bim[4 * q + 3]); } }
}

__device__ __forceinline__ void s5_load(const float* tbl, int l, int g, int lane, float& lbr, float& lbi, float& Lr, float& Li, float (&bre)[16], float (&bim)[16]) {
    const float4* tp = (const float4*)(tbl + ((size_t)((l * 16 + g) * 64 + lane)) * 36);
    const float4 h = tp[0]; lbr = h.x; lbi = h.y; Lr = h.z; Li = h.w;
#pragma unroll
    for (int q = 0; q < 4; ++q) { const float4 a = tp[1 + q], c = tp[5 + q];
        bre[4 * q] = a.x; bre[4 * q + 1] = a.y; bre[4 * q + 2] = a.z; bre[4 * q + 3] = a.w; bim[4 * q] = c.x; bim[4 * q + 1] = c.y; bim[4 * q + 2] = c.z; bim[4 * q + 3] = c.w; }
}

__device__ __forceinline__ void ph_mixA(const KP& p, int l, float* lds) {
    ZDEF;
    const int tid = ltid(), wave = __builtin_amdgcn_readfirstlane(tid >> 6), lane = tid & 63;
    const int gw = blockIdx.x * NWV + wave, NGW = gridDim.x * NWV;
    const float* U = (const float*)(PWS + WS_A);
    const float* ROPE = (const float*)(PWS + WS_ROPE);
    {
        typedef float f32x4v __attribute__((ext_vector_type(4)));
        typedef short bf16x8c __attribute__((ext_vector_type(8)));
        float* red = lds;
        float* hid = lds + 8 * 2048;
        float* w2s = lds + 8 * 2048 + 2048;
        float* KC = (float*)(PWS + WS_KCMP); bf16* VTC = (bf16*)(PWS + WS_VTC);
        const bf16* W1C = (const bf16*)(PWS + WS_WCT);
        for (int item = blockIdx.x; item < 256; item += gridDim.x) {
            const int rt = item & 31, g = (item >> 5) & 1, kv = (item >> 6) & 1, b = item >> 7, n0 = 16 * rt;
            const int arow = lane & 15, kq = lane >> 4;
            const float* pe = PIN(16) + (size_t)l * 4096 + kv * 2048;
            const bf16* wb = W1C + (size_t)kv * 128 * 2048 + (size_t)arow * 2048 + 8 * kq;
            f32x4v acc[8];
#pragma unroll
            for (int ct = 0; ct < 8; ++ct) acc[ct] = (f32x4v){0.f, 0.f, 0.f, 0.f};
#pragma unroll 2
            for (int ksl = 0; ksl < 8; ++ksl) {
                const int k0 = 256 * wave + 32 * ksl + 8 * kq, jt = k0 >> 6, d = k0 & 63;
                const int tok = min(16 * (n0 + arow) + jt, SEQ - 1);
                const float4* up = (const float4*)(U + (size_t)(b * SEQ + tok) * NINP + C_KC + kv * 128 + g * 64 + d);
                const float4* pp = (const float4*)(pe + jt * 64 + d);
                const float4 u0 = up[0], u1 = up[1], p0 = pp[0], p1 = pp[1];
                union { unsigned u[4]; bf16x8c v; } af;
                af.u[0] = pk2(u0.x + p0.x, u0.y + p0.y); af.u[1] = pk2(u0.z + p0.z, u0.w + p0.w); af.u[2] = pk2(u1.x + p1.x, u1.y + p1.y); af.u[3] = pk2(u1.z + p1.z, u1.w + p1.w);
#pragma unroll
                for (int ct = 0; ct < 8; ++ct) { const bf16x8c bfr = *(const bf16x8c*)(wb + (size_t)ct * 16 * 2048 + 256 * wave + 32 * ksl);
                    acc[ct] = __builtin_amdgcn_mfma_f32_16x16x32_bf16(af.v, bfr, acc[ct], 0, 0, 0); }
            }
            __syncthreads();
            { const float4* w2g = (const float4*)((kv ? PIN(20) : PIN(18)) + (size_t)l * 128 * 64);
#pragma unroll
              for (int q = 0; q < 4; ++q) ((float4*)w2s)[tid + 512 * q] = w2g[tid + 512 * q]; }
#pragma unroll
            for (int ct = 0; ct < 8; ++ct)
#pragma unroll
                for (int i = 0; i < 4; ++i) red[(wave * 16 + 4 * kq + i) * 128 + 16 * ct + arow] = acc[ct][i];
            __syncthreads();
#pragma unroll
            for (int q = 0; q < 4; ++q) { const int o = tid + 512 * q; float s = 0.f;
#pragma unroll
                for (int w = 0; w < 8; ++w) s += red[w * 2048 + o];
                hid[o] = gelu_t(s); }
            __syncthreads();
            {
                const int d = lane;
                const float* w2 = w2s + d;
                float o0 = 0.f, o1 = 0.f;
                const float* h0 = hid + (2 * wave) * 128; const float* h1 = h0 + 128;
#pragma unroll 8
                for (int jj = 0; jj < 128; ++jj) { const float w = w2[jj * 64]; o0 += h0[jj] * w; o1 += h1[jj] * w; }
#pragma unroll
                for (int q = 0; q < 2; ++q) { const int n = n0 + 2 * wave + q; float o = q ? o1 : o0;
                    if (kv == 0) {
                        const float y = o * rsqrtf(wsum(o * o) * (1.0f / 64.0f) + EPSN) * PIN(15)[l * 192 + d];
                        const float pr = __shfl_xor(y, 8); const int pos = min(16 * n + 31, SEQ - 1);
                        const float cs = ROPE[pos * 16 + (d & 7)], sn = ROPE[pos * 16 + 8 + (d & 7)];
                        o = d < 8 ? y * cs - pr * sn : (d < 16 ? y * cs + pr * sn : y);
                    }
                    if (n >= 511) o = 0.f;
                    if (kv == 0) { const size_t ki = (size_t)(b * 2 + g) * 32768 + (size_t)(n >> 5) * 2048 + ((((d & 31) >> 3) * 64) + (n & 31) + 32 * (d >> 5)) * 8 + (d & 7);
                        const unsigned hb = f2bf(o); const float lo = o - __uint_as_float(hb << 16);
                        ((bf16*)KC)[ki] = (bf16)hb; ((bf16*)KC)[4 * 32768 + ki] = (bf16)f2bf(lo); }
                    else { const int kk = n & 31, rem = kk & 15, hh2 = (rem >> 2) & 1, e = 4 * (rem >> 3) + (rem & 3);
                        VTC[(size_t)(b * 2 + g) * 32768 + (size_t)(n >> 5) * 2048 + (((d >> 5) * 2 + (kk >> 4)) * 64 + (d & 31) + 32 * hh2) * 8 + e] = (bf16)f2bf(o); } }
            }
        }
        __syncthreads();
    }
    {
        float* ut = lds;
        float* pl = lds + 47 * 256;
        bf16* YMIX = (bf16*)(PWS + WS_XN);
        const int pr_ = lane & 31, ph_ = lane >> 5, pgi = wave >> 1, pdd = pgi * 64 + 32 * (wave & 1) + pr_;
        bf16x8v pwf[4];
#pragma unroll
        for (int ks = 0; ks < 4; ++ks) { const float* wp = PIN(11) + (size_t)l * 16384 + pgi * 4096 + (size_t)(16 * ks + 8 * ph_) * 64 + (pdd & 63);
            union { unsigned u[4]; bf16x8v v; } bf_;
#pragma unroll
            for (int q = 0; q < 4; ++q) bf_.u[q] = pk2(wp[(2 * q) * 64], wp[(2 * q + 1) * 64]);
            pwf[ks] = bf_.v; }
        const float pbv = PIN(12)[l * 256 + pdd], psc = PIN(13)[l * 256 + pdd];
        for (int item = blockIdx.x; item < 512; item += gridDim.x) {
            const int row0 = item * 32, b = row0 >> 13, t0 = row0 & (SEQ - 1);
            for (int i = tid; i < 47 * 64; i += NTHR) { const int r = i >> 6, c4 = i & 63, t = t0 - 15 + r;
                float4 v = make_float4(0.f, 0.f, 0.f, 0.f); if (t >= 0) v = *(const float4*)(U + (size_t)(b * SEQ + t) * NINP + 4 * c4);
                ((float4*)ut)[i] = v; }
            __syncthreads();
            for (int i = tid; i < 32 * 256; i += NTHR) { const int tt = i >> 8, ch = i & 255, gi = ch >> 6, w = 2 << gi, t = t0 + tt; const int cnt = min(t + 1, w);
                float s = 0.f; for (int q = 0; q < cnt; ++q) s += ut[(tt + 15 - q) * 256 + ch];
                pl[i] = s * __builtin_amdgcn_rcpf((float)cnt) - ut[(tt + 15) * 256 + ch]; }
            __syncthreads();
            {
                f32x16 acc;
#pragma unroll
                for (int i = 0; i < 16; ++i) acc[i] = 0.f;
#pragma unroll
                for (int ks = 0; ks < 4; ++ks) { const float* ap = pl + pr_ * 256 + pgi * 64 + 16 * ks + 8 * ph_;
                    const float4 f0 = *(const float4*)ap, f1 = *(const float4*)(ap + 4);
                    union { unsigned u[4]; bf16x8v v; } af; af.u[0] = pk2(f0.x, f0.y); af.u[1] = pk2(f0.z, f0.w); af.u[2] = pk2(f1.x, f1.y); af.u[3] = pk2(f1.z, f1.w);
                    acc = __builtin_amdgcn_mfma_f32_32x32x16_bf16(af.v, pwf[ks], acc, 0, 0, 0); }
                __syncthreads();
#pragma unroll
                for (int i = 0; i < 16; ++i) { const int rr = 8 * (i >> 2) + 4 * ph_ + (i & 3); ut[rr * 256 + pdd] = (acc[i] + pbv) * psc; }
            }
            __syncthreads();
#pragma unroll
            for (int q = 0; q < 4; ++q) { const int tt = 4 * wave + q; float v[4]; float ss = 0.f;
#pragma unroll
                for (int jx = 0; jx < 4; ++jx) { v[jx] = ut[tt * 256 + lane + 64 * jx]; ss += v[jx] * v[jx]; }
                const float rinv = rsqrtf(wsum(ss) * (1.0f / 256.0f) + EPSN);
#pragma unroll
                for (int jx = 0; jx < 4; ++jx) YMIX[(size_t)(row0 + tt) * DM + lane + 64 * jx] = (bf16)f2bf(v[jx] * rinv * PIN(10)[l * DM + lane + 64 * jx]); }
            __syncthreads();
        }
    }
    {
        bf16* VTS = (bf16*)(PWS + WS_VTS); bf16* VTW = (bf16*)(PWS + WS_VTW);
        const int rowid = tid >> 1, hh = tid & 1, kind = rowid >> 7, g = (rowid >> 6) & 1, d = rowid & 63;
        for (int item = blockIdx.x; item < 512; item += gridDim.x) {
            const int row0 = item * 32, b = row0 >> 13, k0 = row0 & (SEQ - 1);
            const float* up = U + (size_t)row0 * NINP + (kind ? C_VW : C_VS) + g * 64 + d;
            unsigned w[8];
#pragma unroll
            for (int s2 = 0; s2 < 2; ++s2)
#pragma unroll
                for (int jp = 0; jp < 4; ++jp) { const int j = 2 * jp; const int ka = 16 * s2 + 8 * (j >> 2) + 4 * hh + (j & 3);
                    w[s2 * 4 + jp] = pk2(up[(size_t)ka * NINP], up[(size_t)(ka + 1) * NINP]); }
            bf16* dst = (kind ? VTW : VTS) + (size_t)(b * 2 + g) * SEQ * 64 + (size_t)(k0 >> 5) * 2048 + (((d >> 5) * 2) * 64 + (d & 31) + 32 * hh) * 8;
            *(uint4*)dst = make_uint4(w[0], w[1], w[2], w[3]); *(uint4*)(dst + 512) = make_uint4(w[4], w[5], w[6], w[7]);
        }
    }
    {
        float* QN = (float*)(PWS + WS_QN); bf16* KS = (bf16*)(PWS + WS_KS); bf16* KW = (bf16*)(PWS + WS_KW);
        const float qg = PIN(14)[l * 64 + lane], ksg = PIN(15)[l * 192 + 64 + lane], kwg = PIN(15)[l * 192 + 128 + lane];
        for (int m0 = gw; m0 < MTOK; m0 += 2 * NGW) {
            float vv[2][12]; float csn[2][2];
#pragma unroll
            for (int e = 0; e < 2; ++e) { const int m = min(m0 + e * NGW, MTOK - 1), t = m & (SEQ - 1); const float* u = U + (size_t)m * NINP;
                csn[e][0] = ROPE[t * 16 + (lane & 7)]; csn[e][1] = ROPE[t * 16 + 8 + (lane & 7)];
#pragma unroll
                for (int h = 0; h < 12; ++h) vv[e][h] = u[h < 8 ? C_Q + h * 64 + lane : (h < 10 ? C_KS + (h - 8) * 64 + lane : C_KW + (h - 10) * 64 + lane)]; }
#pragma unroll
            for (int e = 0; e < 2; ++e) { const int m = m0 + e * NGW, t = m & (SEQ - 1); const float cs = csn[e][0], sn = csn[e][1];
                if (m >= MTOK) continue;
#pragma unroll
                for (int h = 0; h < 12; ++h) {
                    const float v = vv[e][h];
                    const float gn = h < 8 ? qg : (h < 10 ? ksg : kwg);
                    const float y = v * rsqrtf(wsum(v * v) * (1.0f / 64.0f) + EPSN) * gn;
                    const float pr = __int_as_float(__builtin_amdgcn_mov_dpp(__float_as_int(y), 0x128, 0xf, 0xf, true));
                    const float o = lane < 8 ? y * cs - pr * sn : (lane < 16 ? y * cs + pr * sn : y);
                    if (h < 8) QN[(size_t)m * 512 + h * 64 + lane] = o * 0.18033688011112042f;
                    else { const int gg = h & 1, bgi = (m >> 13) * 2 + gg;
                        const size_t di = (size_t)bgi * SEQ * 64 + (size_t)(t >> 5) * 2048 + ((((lane & 31) >> 3) * 64) + (t & 31) + 32 * (lane >> 5)) * 8 + (lane & 7);
                        (h < 10 ? KS : KW)[di] = (bf16)f2bf(o); }
                }
            }
        }
    }
    {
        float* SE = (float*)(PWS + WS_S5END);
        for (int it = gw; it < 4096; it += NGW) {
            const int c = it & 127, g = (it >> 7) & 15, b = it >> 11;
            float lbr, lbi, bre[16], bim[16], Lr_, Li_; s5_load((const float*)(PWS + WS_S5T), l, g, lane, lbr, lbi, Lr_, Li_, bre, bim);
            float xr = 0.f, xi = 0.f;
            const float* up = U + (size_t)(b * SEQ + c * 64) * NINP + C_S5 + g * 16;
            float* us = lds + wave * 1024;
            { const float4* ul = (const float4*)(up + (size_t)lane * NINP); const float4 a0 = ul[0], a1 = ul[1], a2 = ul[2], a3 = ul[3];
              float4* ud = (float4*)(us + lane * 16); ud[0] = a0; ud[1] = a1; ud[2] = a2; ud[3] = a3; }
            LDSW();
            for (int s = 0; s < 64; ++s) {
                const float4* u4 = (const float4*)(us + s * 16);
                float bur = 0.f, bui = 0.f;
#pragma unroll
                for (int q = 0; q < 4; ++q) { const float4 uv = u4[q];
                    bur += bre[4 * q] * uv.x + bre[4 * q + 1] * uv.y + bre[4 * q + 2] * uv.z + bre[4 * q + 3] * uv.w;
                    bui += bim[4 * q] * uv.x + bim[4 * q + 1] * uv.y + bim[4 * q + 2] * uv.z + bim[4 * q + 3] * uv.w; }
                const float nxr = lbr * xr - lbi * xi + bur, nxi = lbr * xi + lbi * xr + bui; xr = nxr; xi = nxi;
            }
            LDSW();
            *(float2*)(SE + ((size_t)((b * 16 + g) * 128 + c) * 64 + lane) * 2) = make_float2(xr, xi);
        }
    }
}

__device__ __forceinline__ unsigned cvtpk(float lo, float hi) { unsigned r; asm volatile("v_cvt_pk_bf16_f32 %0, %1, %2" : "=v"(r) : "v"(lo), "v"(hi)); return r; }
template <bool MASK> __device__ __forceinline__ void sm_update(f32x16& acc, int d1, int d2, float& m, float& ls, f32x16& o0, f32x16& o1, bf16x8v (&pb)[2]) {
    float tmax = -1e30f;
#pragma unroll
    for (int i = 0; i < 16; ++i) { if (MASK) { const int cst = (i & 3) + 8 * (i >> 2); acc[i] = (cst <= d1 && cst > d2) ? acc[i] : -1e30f; } tmax = fmaxf(tmax, acc[i]); }
    tmax = fmaxf(tmax, __shfl_xor(tmax, 32));
    const float mn = fmaxf(m, tmax), alpha = __builtin_amdgcn_exp2f(m - mn);
    float ps = 0.f;
#pragma unroll
    for (int i = 0; i < 16; ++i) { float pv = __builtin_amdgcn_exp2f(acc[i] - mn); if (MASK) pv = acc[i] > -1e29f ? pv : 0.f; acc[i] = pv; ps += pv; }
    ls = ls * alpha + ps; m = mn;
    o0 *= alpha; o1 *= alpha;
#pragma unroll
    for (int s = 0; s < 2; ++s) { union { unsigned u[4]; bf16x8v v; } pk;
#pragma unroll
        for (int q = 0; q < 4; ++q) pk.u[q] = cvtpk(acc[8 * s + 2 * q], acc[8 * s + 2 * q + 1]);
        pb[s] = pk.v; }
}
__device__ __forceinline__ void sm_update_fast(f32x16& acc, bool sel, float& m, float& ls, f32x16& o0, f32x16& o1, bf16x8v (&pb)[2]) {
    float tmax = acc[0];
#pragma unroll
    for (int i = 1; i < 16; ++i) tmax = fmaxf(tmax, acc[i]);
    tmax = sel ? tmax : -1e30f;
    if (__any(tmax > m + 8.0f)) {
        const float t2 = fmaxf(tmax, __shfl_xor(tmax, 32)), mn = fmaxf(m, t2), alpha = __builtin_amdgcn_exp2f(m - mn);
        ls *= alpha; o0 *= alpha; o1 *= alpha; m = mn;
    }
    float ps = 0.f;
#pragma unroll
    for (int i = 0; i < 16; ++i) { const float pv = __builtin_amdgcn_exp2f(acc[i] - m); acc[i] = pv; ps += pv; }
    ls += sel ? ps : 0.f;
#pragma unroll
    for (int s = 0; s < 2; ++s) { union { unsigned u[4]; bf16x8v v; } pk;
#pragma unroll
        for (int q = 0; q < 4; ++q) { const unsigned w = cvtpk(acc[8 * s + 2 * q], acc[8 * s + 2 * q + 1]); pk.u[q] = sel ? w : 0u; }
        pb[s] = pk.v; }
}

__device__ __forceinline__ void nsa_load(const bf16* kbase, const bf16* vbase, int key0, bf16x8v (&kb)[4], bf16x8v (&va)[4], bool noload) {
#ifdef PROBE_NOLOAD
    if (noload) { const short sv = (short)key0;
#pragma unroll
        for (int ks = 0; ks < 4; ++ks) { kb[ks] = (bf16x8v){sv, sv, sv, sv, sv, sv, sv, sv}; va[ks] = kb[ks]; }
        return; }
#endif
    const bf16* kp = kbase + (size_t)(key0 >> 5) * 2048; const bf16* vp = vbase + (size_t)(key0 >> 5) * 2048;
#pragma unroll
    for (int ks = 0; ks < 4; ++ks) { kb[ks] = *(const bf16x8v*)(kp + 512 * ks); va[ks] = *(const bf16x8v*)(vp + 512 * ks); }
}
__device__ __forceinline__ void nsa_compute(const bf16x8v (&kb)[4], const bf16x8v (&va)[4], const bf16x8v (&qb)[4], bool full, bool sel, int d1, int d2, float& m, float& ls, f32x16& o0, f32x16& o1) {
    f32x16 acc;
#pragma unroll
    for (int i = 0; i < 16; ++i) acc[i] = 0.f;
    __builtin_amdgcn_s_setprio(1);
#pragma unroll
    for (int ks = 0; ks < 4; ++ks) acc = __builtin_amdgcn_mfma_f32_32x32x16_bf16(kb[ks], qb[ks], acc, 0, 0, 0);
    __builtin_amdgcn_s_setprio(0);
    bf16x8v pb[2];
    if (full) sm_update_fast(acc, sel, m, ls, o0, o1, pb);
    else sm_update<true>(acc, d1, d2, m, ls, o0, o1, pb);
    __builtin_amdgcn_s_setprio(1);
    o0 = __builtin_amdgcn_mfma_f32_32x32x16_bf16(va[0], pb[0], o0, 0, 0, 0); o1 = __builtin_amdgcn_mfma_f32_32x32x16_bf16(va[2], pb[0], o1, 0, 0, 0);
    o0 = __builtin_amdgcn_mfma_f32_32x32x16_bf16(va[1], pb[1], o0, 0, 0, 0); o1 = __builtin_amdgcn_mfma_f32_32x32x16_bf16(va[3], pb[1], o1, 0, 0, 0);
    __builtin_amdgcn_s_setprio(0);
}

template <bool FIRST> __device__ __forceinline__ void nsa_out(float* op, const f32x16& o0, const f32x16& o1, float sc, bool dry) {
    if (dry) return;
#pragma unroll
    for (int a = 0; a < 4; ++a) {
        float4 v0 = make_float4(o0[4 * a] * sc, o0[4 * a + 1] * sc, o0[4 * a + 2] * sc, o0[4 * a + 3] * sc), v1 = make_float4(o1[4 * a] * sc, o1[4 * a + 1] * sc, o1[4 * a + 2] * sc, o1[4 * a + 3] * sc);
        if (!FIRST) { const float4 p0 = *(const float4*)(op + 8 * a), p1 = *(const float4*)(op + 32 + 8 * a); v0.x += p0.x; v0.y += p0.y; v0.z += p0.z; v0.w += p0.w; v1.x += p1.x; v1.y += p1.y; v1.z += p1.z; v1.w += p1.w; }
        *(float4*)(op + 8 * a) = v0; *(float4*)(op + 32 + 8 * a) = v1; }
}
__device__ __forceinline__ void ph_mixB(const KP& p, int l, float* lds, bool dry, int parts) {
    ZDEF;
    const int tid = ltid(), wave = __builtin_amdgcn_readfirstlane(tid >> 6), lane = tid & 63;
    const int vb = (gridDim.x % 8 == 0) ? (int)(blockIdx.x % 8) * (int)(gridDim.x / 8) + (int)(blockIdx.x / 8) : (int)blockIdx.x;
    const int gw = vb * NWV + wave, NGW = gridDim.x * NWV;
    const float* U = (const float*)(PWS + WS_A);
    float* QN = (float*)(PWS + WS_QN); const bf16* KSb = (const bf16*)(PWS + WS_KS); const bf16* KWb = (const bf16*)(PWS + WS_KW);
    const float* KC = (const float*)(PWS + WS_KCMP);
    const bf16* VTS = (const bf16*)(PWS + WS_VTS); const bf16* VTW = (const bf16*)(PWS + WS_VTW); const bf16* VTC = (const bf16*)(PWS + WS_VTC);
    float* wl = lds + wave * 2112;
    float* Gs = wl; float* Es = wl + 1024; unsigned long long* selm = (unsigned long long*)(wl + 2048);
#ifndef NO_NSA
    if (parts & 1)
    for (int uu = gw; uu < 2048; uu += NGW)
    for (int ui = 0; ui < 2; ++ui) {
        const int bg = uu >> 9, ti = ui == 0 ? (uu & 511) : 1023 - (uu & 511);
        const int b = bg >> 1, g = bg & 1, t0 = ti * 8;
        const int c = lane & 31, h = lane >> 5, ql = c >> 2, r = c & 3;
        const int t = t0 + ql;
        const size_t row = (size_t)b * SEQ + t;
        float qf[32];
        { const float4* qp = (const float4*)(QN + row * 512 + (g * 4 + r) * 64 + 32 * h);
#pragma unroll
          for (int i = 0; i < 8; ++i) { const float4 v = qp[i]; qf[4 * i] = v.x; qf[4 * i + 1] = v.y; qf[4 * i + 2] = v.z; qf[4 * i + 3] = v.w; } }
#pragma unroll
        for (int i = 0; i < 16; ++i) { Gs[64 * i + lane] = 0.f; Es[64 * i + lane] = 0.f; }
        const int nv = (t >= 31) ? ((t - 31) >> 4) + 1 : 0;
        const int nvmax = (t0 + 7 >= 31) ? ((t0 + 7 - 31) >> 4) + 1 : 0, ntile = (nvmax + 31) >> 5;
        const bf16* kcb = (const bf16*)KC + (size_t)bg * 32768 + lane * 8;
        bf16x8v qb[4], qbl[4];
#pragma unroll
        for (int ks = 0; ks < 4; ++ks) { union { unsigned u[4]; bf16x8v v; } ph_, pl_;
#pragma unroll
            for (int q = 0; q < 4; ++q) { const float a0 = qf[8 * ks + 2 * q], a1 = qf[8 * ks + 2 * q + 1]; const unsigned h0 = f2bf(a0), h1 = f2bf(a1);
                ph_.u[q] = h0 | (h1 << 16); pl_.u[q] = pk2(a0 - __uint_as_float(h0 << 16), a1 - __uint_as_float(h1 << 16)); }
            qb[ks] = ph_.v; qbl[ks] = pl_.v; }
        float mc = -1e30f, lc = 0.f;
        bf16x8v kfa[8];
#pragma unroll
        for (int i = 0; i < 4; ++i) { kfa[i] = *(const bf16x8v*)(kcb + 512 * i); kfa[4 + i] = *(const bf16x8v*)(kcb + 4 * 32768 + 512 * i); }
        for (int kt = 0; kt < ntile; ++kt) {
            f32x16 acc;
#pragma unroll
            for (int i = 0; i < 16; ++i) acc[i] = 0.f;
            const bf16* kpn = kcb + (size_t)min(kt + 1, ntile - 1) * 2048;
            bf16x8v kfb[8];
#pragma unroll
            for (int i = 0; i < 4; ++i) { kfb[i] = *(const bf16x8v*)(kpn + 512 * i); kfb[4 + i] = *(const bf16x8v*)(kpn + 4 * 32768 + 512 * i); }
#pragma unroll
            for (int ks = 0; ks < 4; ++ks) { acc = __builtin_amdgcn_mfma_f32_32x32x16_bf16(kfa[ks], qbl[ks], acc, 0, 0, 0); acc = __builtin_amdgcn_mfma_f32_32x32x16_bf16(kfa[4 + ks], qb[ks], acc, 0, 0, 0); }
#pragma unroll
            for (int ks = 0; ks < 4; ++ks) acc = __builtin_amdgcn_mfma_f32_32x32x16_bf16(kfa[ks], qb[ks], acc, 0, 0, 0);
#pragma unroll
            for (int i = 0; i < 8; ++i) kfa[i] = kfb[i];
            const int d1 = nv - 1 - (32 * kt + 4 * h);
            float tmax = -1e30f;
#pragma unroll
            for (int i = 0; i < 16; ++i) { const int cst = (i & 3) + 8 * (i >> 2); acc[i] = cst <= d1 ? acc[i] : -1e30f; tmax = fmaxf(tmax, acc[i]); }
            tmax = fmaxf(tmax, __shfl_xor(tmax, 32));
            const float mn = fmaxf(mc, tmax); float ps = 0.f;
#pragma unroll
            for (int i = 0; i < 16; ++i) ps += acc[i] > -1e29f ? __builtin_amdgcn_exp2f(acc[i] - mn) : 0.f;
            ps += __shfl_xor(ps, 32);
            lc = lc * __builtin_amdgcn_exp2f(mc - mn) + ps; mc = mn;
        }
        const float invc = lc > 0.f ? 1.0f / lc : 0.f;
        const float* gt = U + row * NINP + C_GATE + (g * 4 + r) * 3;
        float* outp = QN + row * 512 + (g * 4 + r) * 64 + 4 * h;
        {
            f32x16 oc0, oc1;
#pragma unroll
            for (int i = 0; i < 16; ++i) { oc0[i] = 0.f; oc1[i] = 0.f; }
            const bf16* vcb = VTC + (size_t)bg * 32768 + lane * 8;
#pragma unroll
            for (int i = 0; i < 4; ++i) { kfa[i] = *(const bf16x8v*)(kcb + 512 * i); kfa[4 + i] = *(const bf16x8v*)(kcb + 4 * 32768 + 512 * i); }
            for (int kt = 0; kt < ntile; ++kt) {
                f32x16 acc;
#pragma unroll
                for (int i = 0; i < 16; ++i) acc[i] = 0.f;
                const bf16* kpn = kcb + (size_t)min(kt + 1, ntile - 1) * 2048;
                bf16x8v kfb[8];
#pragma unroll
                for (int i = 0; i < 4; ++i) { kfb[i] = *(const bf16x8v*)(kpn + 512 * i); kfb[4 + i] = *(const bf16x8v*)(kpn + 4 * 32768 + 512 * i); }
                const bf16x8v va00 = *(const bf16x8v*)(vcb + 2048 * kt), va01 = *(const bf16x8v*)(vcb + 2048 * kt + 512);
                const bf16x8v va10 = *(const bf16x8v*)(vcb + 2048 * kt + 1024), va11 = *(const bf16x8v*)(vcb + 2048 * kt + 1536);
#pragma unroll
                for (int ks = 0; ks < 4; ++ks) { acc = __builtin_amdgcn_mfma_f32_32x32x16_bf16(kfa[ks], qbl[ks], acc, 0, 0, 0); acc = __builtin_amdgcn_mfma_f32_32x32x16_bf16(kfa[4 + ks], qb[ks], acc, 0, 0, 0); }
#pragma unroll
                for (int ks = 0; ks < 4; ++ks) acc = __builtin_amdgcn_mfma_f32_32x32x16_bf16(kfa[ks], qb[ks], acc, 0, 0, 0);
#pragma unroll
                for (int i = 0; i < 8; ++i) kfa[i] = kfb[i];
                const int d1 = nv - 1 - (32 * kt + 4 * h);
#pragma unroll
                for (int i = 0; i < 16; ++i) { const int cst = (i & 3) + 8 * (i >> 2); acc[i] = cst <= d1 ? __builtin_amdgcn_exp2f(acc[i] - mc) * invc : 0.f; }
#pragma unroll
                for (int a = 0; a < 4; ++a) { float G = (acc[4 * a] + acc[4 * a + 1]) + (acc[4 * a + 2] + acc[4 * a + 3]), E = acc[4 * a + 3];
                    G = qsum(G); E = qsum(E);
                    if (r == 0) { const int j = 8 * kt + 2 * a + h; Gs[ql * 128 + j] = G; Es[ql * 128 + j] = E; } }
                bf16x8v pb[2];
#pragma unroll
                for (int s = 0; s < 2; ++s) { union { unsigned u[4]; bf16x8v v; } pk;
#pragma unroll
                    for (int q = 0; q < 4; ++q) pk.u[q] = cvtpk(acc[8 * s + 2 * q], acc[8 * s + 2 * q + 1]);
                    pb[s] = pk.v; }
                oc0 = __builtin_amdgcn_mfma_f32_32x32x16_bf16(va00, pb[0], oc0, 0, 0, 0); oc0 = __builtin_amdgcn_mfma_f32_32x32x16_bf16(va01, pb[1], oc0, 0, 0, 0);
                oc1 = __builtin_amdgcn_mfma_f32_32x32x16_bf16(va10, pb[0], oc1, 0, 0, 0); oc1 = __builtin_amdgcn_mfma_f32_32x32x16_bf16(va11, pb[1], oc1, 0, 0, 0);
            }
            nsa_out<true>(outp, oc0, oc1, sigm(gt[0]), dry);
        }
        LDSW();
        for (int q2 = 0; q2 < 8; ++q2) {
            const int cur = (t0 + q2) >> 6;
            unsigned long long mlo = 0ull, mhi = 0ull;
            if (cur < 16) { mlo = (2ull << cur) - 1ull; }
            else {
                const float* Gq = Gs + q2 * 128; const float* Eq = Es + q2 * 128;
                float v0, v1;
                { const int j = lane; const float im = Gq[j] - 0.5f * Eq[j] + (j > 0 ? 0.5f * Eq[j - 1] : 0.f);
                  const bool forced = (j == 0) || (j == cur) || (j == cur - 1); v0 = (j <= cur) ? (forced ? -INFINITY : im) : -1e30f; }
                { const int j = lane + 64; const float im = Gq[j] - 0.5f * Eq[j] + 0.5f * Eq[j - 1];
                  const bool forced = (j == cur) || (j == cur - 1); v1 = (j <= cur) ? (forced ? -INFINITY : im) : -1e30f; }
                mlo = 1ull;
                if (cur < 64) mlo |= 1ull << cur; else mhi |= 1ull << (cur - 64);
                if (cur - 1 < 64) mlo |= 1ull << (cur - 1); else mhi |= 1ull << (cur - 1 - 64);
                for (int i = 0; i < 13; ++i) {
                    const float mxv = wave_max_dpp(fmaxf(v0, v1));
                    const unsigned long long b0 = __ballot(v0 == mxv);
                    if (b0 != 0ull) { const int ln = __ffsll((long long)b0) - 1; mlo |= 1ull << ln; if (lane == ln) v0 = -INFINITY; }
                    else { const unsigned long long b1 = __ballot(v1 == mxv); const int ln = __ffsll((long long)b1) - 1; mhi |= 1ull << ln; if (lane == ln) v1 = -INFINITY; }
                }
            }
            if (lane == 0) { selm[2 * q2] = mlo; selm[2 * q2 + 1] = mhi; }
        }
        LDSW();
        const unsigned long long mylo = selm[2 * ql], myhi = selm[2 * ql + 1];
        const int jmax = (t0 + 7) >> 6;
        {
            f32x16 o0, o1;
#pragma unroll
            for (int i = 0; i < 16; ++i) { o0[i] = 0.f; o1[i] = 0.f; }
            float m = -1e30f, ls = 0.f;
            const bf16* kbase = KSb + (size_t)bg * SEQ * 64 + lane * 8;
            const bf16* vbase = VTS + (size_t)bg * SEQ * 64 + lane * 8;
            const int smax = (t0 + 7) >> 5;
            bf16x8v kbA[4], vaA[4], kbB[4], vaB[4];
            nsa_load(kbase, vbase, 0, kbA, vaA, dry);
            for (int sj = 0; sj <= smax; sj += 2) {
                nsa_load(kbase, vbase, 32 * min(sj + 1, smax), kbB, vaB, dry);
                {
                    const int j = sj >> 1, key0 = 32 * sj;
                    const bool sel = (((j < 64 ? mylo : myhi) >> (j & 63)) & 1ull) != 0ull;
                    const unsigned long long sb = __ballot(sel);
                    if (sb != 0ull) nsa_compute(kbA, vaA, qb, key0 + 31 <= t0, sel, (sel ? t : -1) - (key0 + 4 * h), -1000000, m, ls, o0, o1);
                }
                nsa_load(kbase, vbase, 32 * min(sj + 2, smax), kbA, vaA, dry);
                if (sj + 1 <= smax) {
                    const int j = sj >> 1, key0 = 32 * (sj + 1);
                    const bool sel = (((j < 64 ? mylo : myhi) >> (j & 63)) & 1ull) != 0ull;
                    const unsigned long long sb = __ballot(sel);
                    if (sb != 0ull) nsa_compute(kbB, vaB, qb, key0 + 31 <= t0, sel, (sel ? t : -1) - (key0 + 4 * h), -1000000, m, ls, o0, o1);
                }
            }
            ls += __shfl_xor(ls, 32);
            nsa_out<false>(outp, o0, o1, sigm(gt[1]) / ls, dry);
        }
        {
            f32x16 o0, o1;
#pragma unroll
            for (int i = 0; i < 16; ++i) { o0[i] = 0.f; o1[i] = 0.f; }
            float m = -1e30f, ls = 0.f;
            const bf16* kbase = KWb + (size_t)bg * SEQ * 64 + lane * 8;
            const bf16* vbase = VTW + (size_t)bg * SEQ * 64 + lane * 8;
            const int s0 = max(t0 - 511, 0) >> 5, s1 = (t0 + 7) >> 5;
            bf16x8v kbA[4], vaA[4], kbB[4], vaB[4];
            nsa_load(kbase, vbase, 32 * s0, kbA, vaA, dry);
            for (int sj = s0; sj <= s1; sj += 2) {
                nsa_load(kbase, vbase, 32 * min(sj + 1, s1), kbB, vaB, dry);
                { const int key0 = 32 * sj;
                  nsa_compute(kbA, vaA, qb, (key0 + 31 <= t0) && (key0 > t0 + 7 - 512), true, t - (key0 + 4 * h), t - 512 - (key0 + 4 * h), m, ls, o0, o1); }
                nsa_load(kbase, vbase, 32 * min(sj + 2, s1), kbA, vaA, dry);
                if (sj + 1 <= s1) { const int key0 = 32 * (sj + 1);
                  nsa_compute(kbB, vaB, qb, (key0 + 31 <= t0) && (key0 > t0 + 7 - 512), true, t - (key0 + 4 * h), t - 512 - (key0 + 4 * h), m, ls, o0, o1); }
            }
            ls += __shfl_xor(ls, 32);
            nsa_out<false>(outp, o0, o1, sigm(gt[2]) / ls, dry);
        }
    }
#endif
#ifndef NO_S5B
    if (parts & 2) {
        typedef float f32x4v __attribute__((ext_vector_type(4)));
        const float* SE = (const float*)(PWS + WS_S5END); float* YS5 = (float*)(PWS + WS_YS5);
        float* us = wl;
        unsigned char* xi_ = (unsigned char*)(wl + 1024);
        for (int it = gw; it < 4096; it += NGW) {
            const int c = it & 127, g = (it >> 7) & 15, b = it >> 11;
            float lbr, lbi, bre[16], bim[16], Lr, Li; s5_load((const float*)(PWS + WS_S5T), l, g, lane, lbr, lbi, Lr, Li, bre, bim);
            const int hcol = lane & 15, kq = lane >> 4;
            bf16x8v cb[4];
#pragma unroll
            for (int ks = 0; ks < 4; ++ks) { const size_t ci = ((size_t)((l * 16 + g) * 16 + hcol)) * 64 + 16 * ks + 4 * kq;
                const float4 cr = *(const float4*)(PIN(26) + ci), cm = *(const float4*)(PIN(27) + ci);
                union { unsigned u[4]; bf16x8v v; } pk; pk.u[0] = pk2(cr.x, -cm.x); pk.u[1] = pk2(cr.y, -cm.y); pk.u[2] = pk2(cr.z, -cm.z); pk.u[3] = pk2(cr.w, -cm.w); cb[ks] = pk.v; }
            float xr = 0.f, xi = 0.f;
            const float* sep = SE + ((size_t)(b * 16 + g) * 128 * 64 + lane) * 2;
            int j = 0;
            for (; j + 16 <= c; j += 16) { float2 eb[16];
#pragma unroll
                for (int q = 0; q < 16; ++q) eb[q] = *(const float2*)(sep + (size_t)(j + q) * 128);
#pragma unroll
                for (int q = 0; q < 16; ++q) { const float nxr = Lr * xr - Li * xi + eb[q].x, nxi = Lr * xi + Li * xr + eb[q].y; xr = nxr; xi = nxi; } }
            for (; j < c; ++j) { const float2 e = *(const float2*)(sep + (size_t)j * 128); const float nxr = Lr * xr - Li * xi + e.x, nxi = Lr * xi + Li * xr + e.y; xr = nxr; xi = nxi; }
            const float* up = U + (size_t)(b * SEQ + c * 64) * NINP + C_S5 + g * 16;
            const float dsk = PIN(28)[l * 256 + g * 16 + hcol];
            { const float4* ul = (const float4*)(up + (size_t)lane * NINP); const float4 a0 = ul[0], a1 = ul[1], a2 = ul[2], a3 = ul[3];
              float4* ud = (float4*)(us + lane * 16); ud[0] = a0; ud[1] = a1; ud[2] = a2; ud[3] = a3; }
            LDSW();
            for (int sc = 0; sc < 4; ++sc) {
#pragma unroll 4
                for (int s2 = 0; s2 < 16; ++s2) {
                    const float4* u4 = (const float4*)(us + (16 * sc + s2) * 16);
                    float bur = 0.f, bui = 0.f;
#pragma unroll
                    for (int q = 0; q < 4; ++q) { const float4 uv = u4[q];
                        bur += bre[4 * q] * uv.x + bre[4 * q + 1] * uv.y + bre[4 * q + 2] * uv.z + bre[4 * q + 3] * uv.w;
                        bui += bim[4 * q] * uv.x + bim[4 * q + 1] * uv.y + bim[4 * q + 2] * uv.z + bim[4 * q + 3] * uv.w; }
                    const float nxr = lbr * xr - lbi * xi + bur, nxi = lbr * xi + lbi * xr + bui; xr = nxr; xi = nxi;
                    *(unsigned*)(xi_ + s2 * 272 + 4 * lane) = cvtpk(xr, xi);
                }
                LDSW();
                f32x4v acc = (f32x4v){0.f, 0.f, 0.f, 0.f};
#pragma unroll
                for (int ks = 0; ks < 4; ++ks) { const bf16x8v af = *(const bf16x8v*)(xi_ + hcol * 272 + (32 * ks + 8 * kq) * 2);
                    acc = __builtin_amdgcn_mfma_f32_16x16x32_bf16(af, cb[ks], acc, 0, 0, 0); }
#pragma unroll
                for (int i = 0; i < 4; ++i) { const int srow = 16 * sc + 4 * kq + i;
                    const float y = gelu_t(acc[i] + dsk * us[srow * 16 + hcol]);
                    YS5[(size_t)(b * SEQ + c * 64 + srow) * 256 + g * 16 + hcol] = y; }
                LDSW();
            }
        }
    }
#endif
}

__device__ __forceinline__ void ph_post(const KP& p, int l, float* lds) {
    ZDEF;
    const int tid = ltid(), wave = __builtin_amdgcn_readfirstlane(tid >> 6), lane = tid & 63;
    const float* ON = (const float*)(PWS + WS_QN); const float* YS5 = (const float*)(PWS + WS_YS5);
    bf16* YMIX = (bf16*)(PWS + WS_XN);
    const float* onorm = PIN(10) + (size_t)l * DM;
    float* ys = lds; float* ob = lds + 32 * 260;
    bf16x8v gfr[16];
    { const bf16* gp = (const bf16*)(PWS + WS_GLUT) + (size_t)(32 * wave + (lane & 31)) * 256 + 8 * (lane >> 5);
#pragma unroll
      for (int ks = 0; ks < 16; ++ks) gfr[ks] = *(const bf16x8v*)(gp + 16 * ks); }
    for (int item = blockIdx.x; item < 512; item += gridDim.x) {
        const int row0 = item * 32;
#pragma unroll
        for (int q = 0; q < 4; ++q) { const size_t row = row0 + 4 * wave + q; const float4* op = (const float4*)(ON + row * 512);
            const float4 v0 = op[lane], v1 = op[64 + lane];
            const float ss = (v0.x * v0.x + v0.y * v0.y) + (v0.z * v0.z + v0.w * v0.w) + (v1.x * v1.x + v1.y * v1.y) + (v1.z * v1.z + v1.w * v1.w);
            const float rinv = rsqrtf(wsum(ss) * (1.0f / 512.0f) + EPSN);
            const float4 g0 = *(const float4*)(onorm + 256 + 4 * lane), g1 = *(const float4*)(onorm + 512 + 4 * lane);
            uint2 o0, o1; o0.x = pk2(v0.x * rinv * g0.x, v0.y * rinv * g0.y); o0.y = pk2(v0.z * rinv * g0.z, v0.w * rinv * g0.w);
            o1.x = pk2(v1.x * rinv * g1.x, v1.y * rinv * g1.y); o1.y = pk2(v1.z * rinv * g1.z, v1.w * rinv * g1.w);
            *(uint2*)(YMIX + row * DM + 256 + 4 * lane) = o0; *(uint2*)(YMIX + row * DM + 512 + 4 * lane) = o1; }
        for (int i = tid; i < 32 * 64; i += NTHR) { const int rr = i >> 6, c4 = i & 63; *(float4*)(ys + rr * 260 + 4 * c4) = ((const float4*)(YS5 + (size_t)row0 * 256))[i]; }
        __syncthreads();
        {
            const int ar = lane & 31, ah = lane >> 5;
            f32x16 acc;
#pragma unroll
            for (int i = 0; i < 16; ++i) acc[i] = 0.f;
#pragma unroll
            for (int ks = 0; ks < 16; ++ks) { const float4 f0 = *(const float4*)(ys + ar * 260 + 16 * ks + 8 * ah), f1 = *(const float4*)(ys + ar * 260 + 16 * ks + 8 * ah + 4);
                union { unsigned u[4]; bf16x8v v; } af; af.u[0] = pk2(f0.x, f0.y); af.u[1] = pk2(f0.z, f0.w); af.u[2] = pk2(f1.x, f1.y); af.u[3] = pk2(f1.z, f1.w);
                acc = __builtin_amdgcn_mfma_f32_32x32x16_bf16(af.v, gfr[ks], acc, 0, 0, 0); }
            const int n = 32 * wave + ar; const float gb = PIN(30)[l * 256 + n];
#pragma unroll
            for (int i = 0; i < 16; ++i) { const int rr = 8 * (i >> 2) + 4 * ah + (i & 3); const float yv = ys[rr * 260 + n]; ob[rr * 256 + n] = yv * sigm(acc[i] + gb); }
        }
        __syncthreads();
#pragma unroll
        for (int q = 0; q < 4; ++q) { const int tt = 4 * wave + q; float v[4]; float ss = 0.f;
#pragma unroll
            for (int jx = 0; jx < 4; ++jx) { v[jx] = ob[tt * 256 + lane + 64 * jx]; ss += v[jx] * v[jx]; }
            const float rinv = rsqrtf(wsum(ss) * (1.0f / 256.0f) + EPSN);
#pragma unroll
            for (int jx = 0; jx < 4; ++jx) YMIX[(size_t)(row0 + tt) * DM + 768 + lane + 64 * jx] = (bf16)f2bf(v[jx] * rinv * onorm[768 + lane + 64 * jx]); }
        __syncthreads();
    }
}


#define LAS __attribute__((address_space(3)))
#define XB_TMO      128
#define XB_XCNT(j)  (256  + 64 * (j))
#define XB_XSUB(j)  (1280 + 64 * (j))
#define XB_XGEN(j)  (2304 + 64 * (j))
#define XB_TOP      3328
#define XB_TOPGEN   3392
#define XCD_BAR_WORDS 3456
#define XB_SPIN_CAP (1u << 18)

__device__ __forceinline__ unsigned xb_ld(unsigned* p)              { return __hip_atomic_load(p, __ATOMIC_RELAXED, __HIP_MEMORY_SCOPE_AGENT); }
__device__ __forceinline__ unsigned xb_add(unsigned* p, unsigned v) { return __hip_atomic_fetch_add(p, v, __ATOMIC_RELAXED, __HIP_MEMORY_SCOPE_AGENT); }
__device__ __forceinline__ unsigned xb_xcc_id() { return (unsigned)__builtin_amdgcn_s_getreg((3 << 11) | 20) & 0xFu; }
#define XB_SPIN(cond, bar) do { unsigned _sp = 0; while (cond) { __builtin_amdgcn_s_sleep(1); \
    if ((++_sp & 255u) == 0u) { if (xb_ld(&(bar)[XB_TMO])) break; if (_sp > XB_SPIN_CAP) { atomicAdd(&(bar)[XB_TMO], 1u); break; } } } } while (0)

struct XcdBarrier {
    unsigned* bar; unsigned x;
    volatile LAS unsigned* st;
};

__device__ __forceinline__ XcdBarrier xcd_barrier_post(unsigned* bar, volatile LAS unsigned* st) {
    XcdBarrier b; b.bar = bar; b.x = xb_xcc_id(); b.st = st;
    if (threadIdx.x == 0) (void)xb_add(&bar[XB_XCNT(b.x)], 1u);
    return b;
}
__device__ __forceinline__ void xcd_barrier_complete(unsigned* bar, unsigned x, unsigned& nloc, unsigned& nx) {
    const unsigned G = gridDim.x * gridDim.y * gridDim.z;
    unsigned sum, cnt, mine, sp = 0u;
    for (;;) {
        sum = 0u; cnt = 0u; mine = 0u;
#pragma unroll
        for (unsigned j = 0; j < 16; ++j) { const unsigned c = xb_ld(&bar[XB_XCNT(j)]); sum += c; cnt += (c > 0u) ? 1u : 0u; mine = (j == x) ? c : mine; }
        if (sum == G) break;
        __builtin_amdgcn_s_sleep(1);
        if ((++sp & 255u) == 0u) { if (xb_ld(&bar[XB_TMO])) break; if (sp > XB_SPIN_CAP) { atomicAdd(&bar[XB_TMO], 1u); break; } }
    }
    nloc = mine > 0u ? mine : 1u; nx = cnt > 0u ? cnt : 1u;
}

__device__ __forceinline__ void xcd_barrier(const XcdBarrier& b) {
    asm volatile("s_waitcnt vmcnt(0)" ::: "memory");
    __syncthreads();
    if (threadIdx.x == 0) {
        unsigned* bar = b.bar;
        __builtin_amdgcn_s_waitcnt(0);
        unsigned nloc = b.st[0], nx = b.st[1];
        if (nloc == 0u) { xcd_barrier_complete(bar, b.x, nloc, nx); b.st[0] = nloc; b.st[1] = nx; }
        const unsigned old = xb_add(&bar[XB_XSUB(b.x)], 1u);
        const unsigned gen = old / nloc;
        if (old + 1u == (gen + 1u) * nloc) {
            __builtin_amdgcn_fence(__ATOMIC_RELEASE, "agent");
            asm volatile("s_waitcnt vmcnt(0)" ::: "memory");
            const unsigned og = xb_add(&bar[XB_TOP], 1u);
            const unsigned tg = og / nx;
            if (og + 1u == (tg + 1u) * nx) xb_add(&bar[XB_TOPGEN], 1u);
            else XB_SPIN(xb_ld(&bar[XB_TOPGEN]) == tg, bar);
            __builtin_amdgcn_fence(__ATOMIC_ACQUIRE, "agent");
            xb_add(&bar[XB_XGEN(b.x)], 1u);
            asm volatile("s_waitcnt vmcnt(0)" ::: "memory");
        } else {
            XB_SPIN(xb_ld(&bar[XB_XGEN(b.x)]) == gen, bar);
            __builtin_amdgcn_fence(__ATOMIC_ACQUIRE, "agent");
            asm volatile("s_waitcnt vmcnt(0)" ::: "memory");
        }
    }
    __syncthreads();
}
constexpr int NPHASE = 25;
#ifndef EN_MASK
#define EN_MASK 0xff
#endif
__global__ void __launch_bounds__(NTHR, 2) mk_fwd(KP p) {
    extern __shared__ __attribute__((aligned(16))) unsigned char smem[];
    cg::grid_group grid = cg::this_grid();
    float* ldsf = (float*)smem;
    PG8_LAS unsigned char* ldsl = (PG8_LAS unsigned char*)smem;
    volatile LAS unsigned* bst = (volatile LAS unsigned*)((LAS unsigned char*)smem + (LDS_BYTES - 128));
    if (threadIdx.x < 2) bst[threadIdx.x] = 0u;
    __syncthreads();
    XcdBarrier xbar = xcd_barrier_post((unsigned*)((unsigned char*)p.in[35] + WS_CTL), bst);
    for (int ph = p.ph_lo; ph < p.ph_hi; ++ph) {
        ZDEF;
        const float* modall = (const float*)(PWS + WS_MOD);
        bf16* XN = (bf16*)(PWS + WS_XN);
        int reps = 1;
#ifdef REPEAT_MASK
        { const int s_ = ph == 0 ? -1 : (ph - 1) % 12;
          const int bit = ph == 0 ? 1 : s_ == 0 ? 2 : (s_ == 3 || s_ == 9) ? 4 : s_ == 5 ? 8 : s_ == 6 ? 16 : s_ == 7 ? 32 : (s_ == 1 || s_ == 10) ? 64 : s_ == 4 ? 128 : 0;
          if (REPEAT_MASK & bit) reps = 2; }
#endif
        for (int rep = 0; rep < reps; ++rep) {
        const bool dry = (rep + 1 < reps);
        if (ph == 0) { if (EN_MASK & 1) ph_mod_rope(p, ldsf); ph_s5_table(p); }
        else {
            const int l = (ph - 1) / 12, s = (ph - 1) % 12;
            const float* modl = modall + (size_t)l * 2 * NMOD;
            const float* xin = (l == 0 && s <= 2) ? PIN(0) : POUT;
            if (s == 0) { if (EN_MASK & 2) ph_convert(p, l, ldsf); ph_norm(xin, PIN(4) + l * DM, modl, 0, XN); }
            else if (s == 3) { ph_norm(POUT, PIN(7) + l * DM, modl, 3, XN); }
            else if (s == 9) { ph_norm(POUT, PIN(31) + l * DM, modl, 6, XN); }
            else if ((EN_MASK & 4) && (s == 1 || s == 10)) {
                const int f = s == 1 ? 0 : 1;
                pg8::Gemm g{XN, (const bf16*)(PWS + WS_W1T) + (size_t)f * 2 * DFF * DM, MTOK, 2 * DFF, DM}; pg8::StaticOrder S; S.init(MTOK, 2 * DFF, gridDim.x, blockIdx.x);
                pg8::EpiSwiGLU E{(bf16*)(PWS + WS_A), DFF};
                pg8::gemm_phase<pg8::EpiSwiGLU, pg8::StaticOrder, true, true>(ldsl, g, S, E);
            }
            else if ((EN_MASK & 64) && (s == 2 || s == 11 || s == 8)) {
                const bf16* A = s == 8 ? (const bf16*)XN : (const bf16*)(PWS + WS_A);
                const bf16* Bt = s == 8 ? (const bf16*)(PWS + WS_WOUTT) : (const bf16*)(PWS + WS_W2T) + (size_t)(s == 2 ? 0 : 1) * DM * DFF;
                const int K = s == 8 ? DM : DFF;
                const int gi = s == 2 ? 2 : (s == 8 ? 5 : 8);
                pg8::Gemm g{A, Bt, MTOK, DM, K}; pg8::StaticOrder S; S.init(MTOK, DM, gridDim.x, blockIdx.x);
                pg8::EpiResid E{xin, POUT, modl + gi * DM, NMOD, s == 8 ? 1.0f : 0.5f, DM};
                pg8::gemm_phase<pg8::EpiResid, pg8::StaticOrder, true, true>(ldsl, g, S, E);
            }
            else if ((EN_MASK & 128) && s == 4) {
                pg8::Gemm g{XN, (const bf16*)(PWS + WS_WINT), MTOK, NINP, DM}; pg8::StaticOrder S; S.init(MTOK, NINP, gridDim.x, blockIdx.x);
                pg8::EpiF32 E{(float*)(PWS + WS_A), NINP};
                pg8::gemm_phase<pg8::EpiF32, pg8::StaticOrder, true, true>(ldsl, g, S, E);
            }
            else if ((EN_MASK & 8) && s == 5) { ph_mixA(p, l, ldsf); }
            else if ((EN_MASK & 16) && s == 6) {
#ifdef MIXB_DRY_PARTS
                ph_mixB(p, l, ldsf, dry, dry ? MIXB_DRY_PARTS : 3);
#else
                ph_mixB(p, l, ldsf, dry, 3);
#endif
            }
            else if ((EN_MASK & 32) && s == 7) { ph_post(p, l, ldsf); }
        }
        if (rep + 1 < reps) grid.sync();
        }
        if (ph + 1 < p.ph_hi) { if (ph == p.ph_lo) grid.sync(); else xcd_barrier(xbar); }
    }
}

extern "C" void kernel_launch(void* const* d_in, const int* in_sizes, int n_in, void* d_out, int out_size, void* d_ws, size_t ws_size, hipStream_t stream) {
    static int grid = 0;
    if (grid == 0) {
        if (n_in != 34 || out_size != MTOK * DM || ws_size < WS_END) { fprintf(stderr, "kernel_launch: unexpected shapes (n_in %d out %d ws %zu)\n", n_in, out_size, ws_size); grid = -1; return; }
        int dev = 0, cus = 0, per_cu = 0;
        hipGetDevice(&dev); hipDeviceGetAttribute(&cus, hipDeviceAttributeMultiprocessorCount, dev);
        if (hipFuncSetAttribute((const void*)mk_fwd, hipFuncAttributeMaxDynamicSharedMemorySize, LDS_BYTES) != hipSuccess) { fprintf(stderr, "kernel_launch: hipFuncSetAttribute failed\n"); }
        if (hipOccupancyMaxActiveBlocksPerMultiprocessor(&per_cu, (const void*)mk_fwd, NTHR, LDS_BYTES) != hipSuccess || per_cu < 1) { fprintf(stderr, "kernel_launch: occupancy query says %d\n", per_cu); per_cu = 1; }
        (void)hipGetLastError();
        grid = cus * 1;
        if (grid <= 0) grid = 256;
    }
    if (grid < 0) return;
    KP a{};
    for (int i = 0; i < 34; ++i) a.in[i] = (const float*)d_in[i];
    a.in[34] = (const float*)d_out; a.in[35] = (const float*)d_ws;
#if MK_MULTI
    for (int ph = 0; ph < NPHASE; ++ph) { a.ph_lo = ph; a.ph_hi = ph + 1; hipLaunchKernelGGL(mk_fwd, dim3(grid), dim3(NTHR), LDS_BYTES, stream, a); }
#else
    a.ph_lo = 0; a.ph_hi = NPHASE;
    if (hipMemsetAsync((unsigned char*)d_ws + WS_CTL, 0, CTL_BYTES, stream) != hipSuccess) fprintf(stderr, "kernel_launch: memset failed\n");
    void* args[] = {&a};
    hipError_t e = hipLaunchCooperativeKernel((const void*)mk_fwd, dim3(grid), dim3(NTHR), args, LDS_BYTES, stream);
    if (e != hipSuccess) fprintf(stderr, "kernel_launch: cooperative launch failed: %s (grid %d)\n", hipGetErrorString(e), grid);
#endif
}
```
